# Optimizing an MI355X kernel written in HIP

```python
import math
import jax, jax.numpy as jnp
from jax import lax
import numpy as np

D_MODEL = 1024
BATCH = 16
SEQ = 2048
DEPTH = 2

CHUNK = 64
HEAD_DIM = 64
M_HEADS = 4
R_HEADS = 6
W_HEADS = 6
M_WIDTH = M_HEADS * HEAD_DIM
R_WIDTH = R_HEADS * HEAD_DIM
W_WIDTH = W_HEADS * HEAD_DIM
MIX_WIDTH = M_WIDTH + R_WIDTH + W_WIDTH
CONV_WIDTH = 4
W_LORA = 64
A_LORA = 64
G_LORA = 128
D_FF = -(-8 * D_MODEL // (3 * 256)) * 256
M_COLS = 4 * M_WIDTH + 2 * M_HEADS
R_COLS = 4 * R_WIDTH
W_COLS = 3 * W_WIDTH + W_LORA + A_LORA + G_LORA
P_COLS = M_COLS + R_COLS + W_COLS
RMS_EPS = 1e-6
HEAD_LN_EPS = 1e-5
RWKV_LN_EPS = 64e-5
ROPE_BASE = 10000.0
M_INIT = -1e30

kernel_name = "hybrid_mlstm_retention_rwkv7_trunk"


def rmsnorm(x, g):
    xf = x.astype(jnp.float32)
    y = xf * lax.rsqrt(jnp.mean(xf * xf, axis=-1, keepdims=True) + RMS_EPS) * g.astype(jnp.float32)
    return y.astype(x.dtype)


def head_layernorm(x, n_heads, eps):
    B, T, C = x.shape
    xh = x.astype(jnp.float32).reshape(B, T, n_heads, C // n_heads)
    mu = jnp.mean(xh, axis=-1, keepdims=True)
    var = jnp.mean(jnp.square(xh - mu), axis=-1, keepdims=True)
    return ((xh - mu) * lax.rsqrt(var + eps)).reshape(B, T, C)


def causal_depthwise_conv(x, w):
    K, C = w.shape
    return lax.conv_general_dilated(
        x, w.astype(x.dtype)[:, None, :], window_strides=(1,), padding=[(K - 1, 0)],
        dimension_numbers=("NWC", "WIO", "NWC"), feature_group_count=C)


def to_chunks(x, n_heads):
    B, T, C = x.shape
    return x.reshape(B, T // CHUNK, CHUNK, n_heads, C // n_heads).transpose(1, 0, 3, 2, 4)


def from_chunks(y):
    NC, B, H, L, d = y.shape
    return y.transpose(1, 0, 3, 2, 4).reshape(B, NC * L, H * d)


def gate_chunks(g):
    B, T, H = g.shape
    return g.reshape(B, T // CHUNK, CHUNK, H).transpose(1, 0, 3, 2)


def mlstm_chunkwise(q, k, v, i_pre, log_f):
    B, T, _ = q.shape
    H, d = M_HEADS, HEAD_DIM
    causal = jnp.tril(jnp.ones((CHUNK, CHUNK), dtype=bool))

    def step(carry, inp):
        C, n, m = carry
        qc, kc, vc, ic, lfc = inp
        b = jnp.cumsum(lfc, axis=-1)
        dlog = jnp.where(causal, b[..., :, None] - b[..., None, :] + ic[..., None, :], -jnp.inf)
        inter = b + m[..., None]
        m_row = jnp.maximum(inter, jnp.max(dlog, axis=-1))
        s = jnp.einsum('bhjd,bhsd->bhjs', qc, kc) * jnp.exp(dlog - m_row[..., None])
        inter_w = jnp.exp(inter - m_row)
        num = jnp.einsum('bhjs,bhse->bhje', s, vc) + inter_w[..., None] * jnp.einsum('bhjd,bhde->bhje', qc, C)
        den = jnp.sum(s, axis=-1) + inter_w * jnp.einsum('bhjd,bhd->bhj', qc, n)
        h = num / jnp.maximum(jnp.abs(den), jnp.exp(-m_row))[..., None]
        bL = b[..., -1]
        src = bL[..., None] - b + ic
        m_new = jnp.maximum(bL + m, jnp.max(src, axis=-1))
        sw = jnp.exp(src - m_new[..., None])
        dec = jnp.exp(bL + m - m_new)
        C_new = dec[..., None, None] * C + jnp.einsum('bhs,bhsd,bhse->bhde', sw, kc, vc)
        n_new = dec[..., None] * n + jnp.einsum('bhs,bhsd->bhd', sw, kc)
        return (C_new, n_new, m_new), h

    init = (jnp.zeros((B, H, d, d), jnp.float32), jnp.zeros((B, H, d), jnp.float32),
            jnp.full((B, H), M_INIT, jnp.float32))
    xs = (to_chunks(q, H), to_chunks(k, H), to_chunks(v, H), gate_chunks(i_pre), gate_chunks(log_f))
    _, h = lax.scan(step, init, xs)
    return from_chunks(h)


def mlstm_group(p, conv_w, b_i, b_f, ln_g):
    p = p.astype(jnp.float32)
    qk, v, o, gi, gf = jnp.split(p, [2 * M_WIDTH, 3 * M_WIDTH, 4 * M_WIDTH, 4 * M_WIDTH + M_HEADS], axis=-1)
    qk = jax.nn.silu(causal_depthwise_conv(qk, conv_w))
    q, k = jnp.split(qk, 2, axis=-1)
    i_pre = gi + b_i.astype(jnp.float32)
    log_f = jax.nn.log_sigmoid(gf + b_f.astype(jnp.float32))
    h = mlstm_chunkwise(q, k * HEAD_DIM ** -0.5, v, i_pre, log_f)
    h = head_layernorm(h, M_HEADS, HEAD_LN_EPS) * ln_g.astype(jnp.float32)
    return jax.nn.sigmoid(o) * h


def rotary(x, cos, sin):
    x1, x2 = jnp.split(x, 2, axis=-1)
    c, s = cos[None, :, None, :], sin[None, :, None, :]
    return jnp.concatenate([x1 * c - x2 * s, x1 * s + x2 * c], axis=-1)


def retention_group(p):
    p = p.astype(jnp.float32)
    B, T, _ = p.shape
    H, d = R_HEADS, HEAD_DIM
    q, k, v, g = jnp.split(p, 4, axis=-1)
    pos = jnp.arange(T, dtype=jnp.float32)
    theta = 1.0 / (ROPE_BASE ** jnp.linspace(0.0, 1.0, d // 2, dtype=jnp.float32))
    ang = pos[:, None] * theta[None, :]
    cos, sin = jnp.cos(ang), jnp.sin(ang)
    q = rotary(q.reshape(B, T, H, d), cos, sin).reshape(B, T, H * d)
    k = rotary(k.reshape(B, T, H, d), cos, sin).reshape(B, T, H * d) * d ** -0.5
    log_g = jnp.log(1.0 - 2.0 ** (-5.0 - jnp.arange(H, dtype=jnp.float32)))
    idx = jnp.arange(CHUNK, dtype=jnp.float32)
    diff = idx[:, None] - idx[None, :]
    dmat = jnp.where(diff >= 0, jnp.exp(jnp.maximum(diff, 0.0)[None] * log_g[:, None, None]), 0.0)
    q_dec = jnp.exp((idx[None, :] + 1.0) * log_g[:, None])[None, :, :, None]
    k_dec = jnp.exp((CHUNK - 1.0 - idx[None, :]) * log_g[:, None])[None, :, :, None]
    c_dec = jnp.exp(CHUNK * log_g)[None, :, None, None]

    def step(R, inp):
        qc, kc, vc = inp
        s = jnp.einsum('bhjd,bhsd->bhjs', qc, kc) * dmat
        out = jnp.einsum('bhjs,bhse->bhje', s, vc) + jnp.einsum('bhjd,bhde->bhje', qc, R) * q_dec
        R_new = c_dec * R + jnp.einsum('bhsd,bhse->bhde', kc * k_dec, vc)
        return R_new, out

    R0 = jnp.zeros((B, H, d, d), jnp.float32)
    _, y = lax.scan(step, R0, (to_chunks(q, H), to_chunks(k, H), to_chunks(v, H)))
    y = head_layernorm(from_chunks(y), H, HEAD_LN_EPS)
    return jax.nn.silu(g) * y


def rwkv7_group(p, mu, w0, w_up, a0, a_up, g_up, k_k, k_a, r_k, ln_g, ln_b):
    p = p.astype(jnp.float32)
    B, T, _ = p.shape
    H, d = W_HEADS, HEAD_DIM
    p_prev = jnp.pad(p, ((0, 0), (1, 0), (0, 0)))[:, :-1]
    p = p + mu.astype(jnp.float32) * (p_prev - p)
    r, k, v, wl, al, gl = jnp.split(
        p, [W_WIDTH, 2 * W_WIDTH, 3 * W_WIDTH, 3 * W_WIDTH + W_LORA, 3 * W_WIDTH + W_LORA + A_LORA], axis=-1)
    w_log = -jax.nn.softplus(-(w0 + jnp.tanh(wl) @ w_up.astype(jnp.float32))) - 0.5
    decay = jnp.exp(-jnp.exp(w_log))
    a = jax.nn.sigmoid(a0 + al @ a_up.astype(jnp.float32))
    g = jax.nn.sigmoid(gl) @ g_up.astype(jnp.float32)
    kk = (k * k_k).reshape(B, T, H, d)
    kk = kk / jnp.maximum(jnp.sqrt(jnp.sum(kk * kk, axis=-1, keepdims=True)), 1e-12)
    k = k * (1.0 + (a - 1.0) * k_a)

    def heads_t(z):
        return z.reshape(B, T, H, d).transpose(1, 0, 2, 3)

    def step(S, inp):
        r_t, w_t, k_t, v_t, kk_t, a_t = inp
        S = (S * w_t[:, :, None, :]
             - jnp.einsum('bhvk,bhk->bhv', S, kk_t)[..., None] * (kk_t * a_t)[:, :, None, :]
             + v_t[..., :, None] * k_t[..., None, :])
        return S, jnp.einsum('bhvk,bhk->bhv', S, r_t)

    S0 = jnp.zeros((B, H, d, d), jnp.float32)
    xs = (heads_t(r), heads_t(decay), heads_t(k), heads_t(v), kk.transpose(1, 0, 2, 3), heads_t(a))
    _, y = lax.scan(step, S0, xs)
    y = y.transpose(1, 0, 2, 3).reshape(B, T, H * d)
    y = head_layernorm(y, H, RWKV_LN_EPS) * ln_g + ln_b
    bonus = jnp.sum(r.reshape(B, T, H, d) * k.reshape(B, T, H, d) * r_k.reshape(H, d), axis=-1, keepdims=True)
    y = y + (bonus * v.reshape(B, T, H, d)).reshape(B, T, H * d)
    return y * g


def setup_inputs(seed: int = 0) -> dict:
    key = jax.random.key(seed)
    ks = jax.random.split(key, 24)
    f32 = jnp.float32
    nrm = lambda k, shape, s: jax.random.normal(k, shape, f32) * s
    w0_base = jnp.linspace(-5.5, 0.5, W_WIDTH, dtype=f32)
    bf_base = jnp.linspace(3.0, 6.0, M_HEADS, dtype=f32)
    return {
        "x": nrm(ks[0], (BATCH, SEQ, D_MODEL), 1.0),
        "w_in": nrm(ks[1], (DEPTH, D_MODEL, P_COLS), D_MODEL ** -0.5),
        "ln1_g": 1.0 + nrm(ks[2], (DEPTH, D_MODEL), 0.02),
        "ln2_g": 1.0 + nrm(ks[3], (DEPTH, D_MODEL), 0.02),
        "lnf_g": 1.0 + nrm(ks[4], (D_MODEL,), 0.02),
        "m_conv": nrm(ks[5], (DEPTH, CONV_WIDTH, 2 * M_WIDTH), CONV_WIDTH ** -0.5),
        "m_b_i": nrm(ks[6], (DEPTH, M_HEADS), 0.1),
        "m_b_f": bf_base + nrm(ks[7], (DEPTH, M_HEADS), 0.1),
        "m_ln_g": 1.0 + nrm(ks[8], (DEPTH, M_WIDTH), 0.02),
        "rw_mu": jax.random.uniform(ks[9], (DEPTH, W_COLS), f32),
        "rw_w0": w0_base + nrm(ks[10], (DEPTH, W_WIDTH), 0.1),
        "rw_w_up": nrm(ks[11], (DEPTH, W_LORA, W_WIDTH), 0.1),
        "rw_a0": nrm(ks[12], (DEPTH, W_WIDTH), 0.1),
        "rw_a_up": nrm(ks[13], (DEPTH, A_LORA, W_WIDTH), 0.1),
        "rw_g_up": nrm(ks[14], (DEPTH, G_LORA, W_WIDTH), G_LORA ** -0.5),
        "rw_k_k": 0.85 + nrm(ks[15], (DEPTH, W_WIDTH), 0.02),
        "rw_k_a": 1.0 + nrm(ks[16], (DEPTH, W_WIDTH), 0.02),
        "rw_r_k": nrm(ks[17], (DEPTH, W_WIDTH), 0.1),
        "rw_ln_g": 1.0 + nrm(ks[18], (DEPTH, W_WIDTH), 0.02),
        "rw_ln_b": nrm(ks[19], (DEPTH, W_WIDTH), 0.01),
        "w_out": nrm(ks[20], (DEPTH, MIX_WIDTH, D_MODEL), MIX_WIDTH ** -0.5),
        "w_gate": nrm(ks[21], (DEPTH, D_MODEL, D_FF), D_MODEL ** -0.5),
        "w_up": nrm(ks[22], (DEPTH, D_MODEL, D_FF), D_MODEL ** -0.5),
        "w_down": nrm(ks[23], (DEPTH, D_FF, D_MODEL), D_FF ** -0.5),
    }


def reference(x, w_in, ln1_g, ln2_g, lnf_g, m_conv, m_b_i, m_b_f, m_ln_g, rw_mu, rw_w0, rw_w_up,
              rw_a0, rw_a_up, rw_g_up, rw_k_k, rw_k_a, rw_r_k, rw_ln_g, rw_ln_b, w_out, w_gate,
              w_up, w_down):
    for l in range(DEPTH):
        h = rmsnorm(x, ln1_g[l])
        p = h @ w_in[l]
        pm, pr, pw = jnp.split(p, [M_COLS, M_COLS + R_COLS], axis=-1)
        ym = mlstm_group(pm, m_conv[l], m_b_i[l], m_b_f[l], m_ln_g[l])
        yr = retention_group(pr)
        yw = rwkv7_group(pw, rw_mu[l], rw_w0[l], rw_w_up[l], rw_a0[l], rw_a_up[l], rw_g_up[l],
                         rw_k_k[l], rw_k_a[l], rw_r_k[l], rw_ln_g[l], rw_ln_b[l])
        y = jnp.concatenate([ym, yr, yw], axis=-1).astype(x.dtype)
        x = x + y @ w_out[l]
        h = rmsnorm(x, ln2_g[l])
        x = x + (jax.nn.silu(h @ w_gate[l]) * (h @ w_up[l])) @ w_down[l]
    return rmsnorm(x, lnf_g)
```

```cpp
#include <hip/hip_runtime.h>
#include <cstdio>
#include <cstdint>
#include <cmath>
#define MK_N_LAUNCHES 12
namespace pg8 {
#define PG8_LAS __attribute__((address_space(3)))
typedef unsigned short bf16_t;
typedef short bf16x8 __attribute__((ext_vector_type(8)));
typedef float f32x4 __attribute__((ext_vector_type(4)));
typedef unsigned u32x4 __attribute__((ext_vector_type(4)));
constexpr int BM = 256, BK = 64, HALF = 128, HTB = HALF * BK * 2  , STAGE_BYTES = 8 * HTB, NXCD = 8, WGM = 8;

__host__ __device__ __forceinline__ int lds_byte(int r, int c) { const int st = (r >> 4) * 2 + (c >> 5), rr = r & 15, cc = c & 31, ob = rr * 64 + cc * 2; return st * 1024 + (ob ^ (((ob >> 9) & 1) << 5)); }
__host__ __device__ __forceinline__ void stage_rc(int b, int& R, int& C) { const int st = b / 1024, sb = b % 1024, swz = sb ^ (((sb >> 9) & 1) << 5); R = (st >> 1) * 16 + swz / 64; C = (st & 1) * 32 + (swz % 64) / 2; }
__host__ __device__ __forceinline__ int perm32(int rho) { const int n = rho >> 4, i = rho & 15; return 8 * (i >> 2) + 4 * n + (i & 3); }

struct Unit { int pm, pn; };
struct Gemm { const bf16_t* A; const bf16_t* Bt; int M, N, K; };

struct StaticOrder {
    int nM, nN, nwg, G, c;
    __host__ __device__ void init(int M, int N, int G_, int c_) { nM = M / BM; nN = N / BM; nwg = nM * nN; G = G_; c = c_; }
    __host__ __device__ bool next(int i, Unit& u) const {
        const long L = (long)i * G + c; if (L >= nwg) return false;
        int wgid = (int)L; { const int q = nwg / NXCD, r = nwg % NXCD, xcd = wgid % NXCD, off = wgid / NXCD; wgid = (xcd < r ? xcd * (q + 1) : r * (q + 1) + (xcd - r) * q) + off; }
        const int nig = WGM * nN, gid = wgid / nig, fm = gid * WGM, gsz = (nM - fm) < WGM ? (nM - fm) : WGM;
        u.pm = fm + ((wgid % nig) % gsz); u.pn = (wgid % nig) / gsz; return true;
    }
    __device__ __forceinline__ void a_ready(const Unit&) const {}
    __device__ __forceinline__ void done(const Unit&) const {}
};
__device__ __forceinline__ unsigned cvt_pk_bf16(float lo, float hi) { unsigned r; asm volatile("v_cvt_pk_bf16_f32 %0, %1, %2" : "=v"(r) : "v"(lo), "v"(hi)); return r; }
typedef float f32x2 __attribute__((ext_vector_type(2)));
typedef unsigned u32x2 __attribute__((ext_vector_type(2)));
constexpr float RMS_EPS_F = 1e-6f;
__device__ __forceinline__ float row_rstd(const float* rowss, int row) { return __builtin_amdgcn_rsqf(rowss[row] * (1.0f / 1024.0f) + RMS_EPS_F); }
__device__ __forceinline__ float silu_f(float g) { return g * __builtin_amdgcn_rcpf(1.0f + __expf(-g)); }

struct EpiP {
    static constexpr bool PERM = true, AFTER_DRAIN = false;
    bf16_t* O; int ldc; const float* rowss;
    __device__ __forceinline__ void operator()(const f32x4 (&acc)[2][2][4][2], const Unit& u, int wr, int wc, int fr, int fq) const {
        const int row0 = u.pm * BM + wr * 64 + fr, col0 = u.pn * BM + wc * 32 + 8 * fq;
#pragma unroll
        for (int ai = 0; ai < 2; ++ai)
#pragma unroll
            for (int m = 0; m < 4; ++m) { const int row = row0 + ai * HALF + m * 16; const float rs = row_rstd(rowss, row); bf16_t* rowp = O + (size_t)row * ldc + col0;
#pragma unroll
                for (int bj = 0; bj < 2; ++bj) { const f32x4 v0 = acc[ai][bj][m][0] * rs, v1 = acc[ai][bj][m][1] * rs;
                    u32x4 w; w.x = cvt_pk_bf16(v0[0], v0[1]); w.y = cvt_pk_bf16(v0[2], v0[3]); w.z = cvt_pk_bf16(v1[0], v1[1]); w.w = cvt_pk_bf16(v1[2], v1[3]);
                    *(u32x4*)(rowp + bj * HALF) = w; } }
    }
};
struct EpiSwiGLU {
    static constexpr bool PERM = true, AFTER_DRAIN = false;
    bf16_t* H; int ldh; const float* rowss;
    __device__ __forceinline__ void operator()(const f32x4 (&acc)[2][2][4][2], const Unit& u, int wr, int wc, int fr, int fq) const {
        const int row0 = u.pm * BM + wr * 64 + fr, col0 = u.pn * HALF + wc * 32 + 8 * fq;
#pragma unroll
        for (int ai = 0; ai < 2; ++ai)
#pragma unroll
            for (int m = 0; m < 4; ++m) { const int row = row0 + ai * HALF + m * 16; const float rs = row_rstd(rowss, row);
                float h[8];
#pragma unroll
                for (int n = 0; n < 2; ++n)
#pragma unroll
                    for (int j = 0; j < 4; ++j) { const float g = acc[ai][0][m][n][j] * rs, up = acc[ai][1][m][n][j] * rs; h[4 * n + j] = silu_f(g) * up; }
                u32x4 w; w.x = cvt_pk_bf16(h[0], h[1]); w.y = cvt_pk_bf16(h[2], h[3]); w.z = cvt_pk_bf16(h[4], h[5]); w.w = cvt_pk_bf16(h[6], h[7]);
                *(u32x4*)(H + (size_t)row * ldh + col0) = w; }
    }
};
template <bool NORM> struct EpiRes {
    static constexpr bool PERM = false, AFTER_DRAIN = false;
    const float* base; float* out; bf16_t* xn; const float* gain; float* rowss; int ldc;
    __device__ __forceinline__ void operator()(const f32x4 (&acc)[2][2][4][2], const Unit& u, int wr, int wc, int fr, int fq) const {
        const int col0 = u.pn * BM + wc * 32 + 4 * fq;
        f32x4 gv[2][2];
        if (NORM) {
#pragma unroll
            for (int bj = 0; bj < 2; ++bj)
#pragma unroll
                for (int n = 0; n < 2; ++n) gv[bj][n] = *(const f32x4*)(gain + col0 + bj * HALF + n * 16);
        }
#pragma unroll
        for (int ai = 0; ai < 2; ++ai)
#pragma unroll
            for (int m = 0; m < 4; ++m) { const int row = u.pm * BM + ai * HALF + wr * 64 + m * 16 + fr; const size_t off = (size_t)row * ldc + col0; float ss = 0.f;
#pragma unroll
                for (int bj = 0; bj < 2; ++bj)
#pragma unroll
                    for (int n = 0; n < 2; ++n) { const f32x4 bs = *(const f32x4*)(base + off + bj * HALF + n * 16); const f32x4 o = bs + acc[ai][bj][m][n];
                        *(f32x4*)(out + off + bj * HALF + n * 16) = o;
                        if (NORM) { ss += (o[0] * o[0] + o[1] * o[1]) + (o[2] * o[2] + o[3] * o[3]); const f32x4 w = o * gv[bj][n];
                            u32x2 pw; pw.x = cvt_pk_bf16(w[0], w[1]); pw.y = cvt_pk_bf16(w[2], w[3]); *(u32x2*)(xn + off + bj * HALF + n * 16) = pw; } }
                if (NORM) { ss += __shfl_xor(ss, 16); ss += __shfl_xor(ss, 32); if (fq == 0) atomicAdd(rowss + row, ss); }
                if (m & 1) asm volatile("" ::: "memory"); }
    }
};
template <class Epi, class Sched, bool ALIGN_EPI = false, bool SP2 = false>
__device__ __forceinline__ void gemm_phase(PG8_LAS unsigned char* lds, const Gemm g, const Sched& S, const Epi& E) {
    int tid_ = threadIdx.x; asm volatile("" : "+v"(tid_));
    const int tid = tid_, wid = __builtin_amdgcn_readfirstlane(tid >> 6), lane = tid & 63, wr = wid >> 2, wc = wid & 3, fr = lane & 15, fq = lane >> 4;
    const int K = g.K, nt = K / BK;
    unsigned voffA[2], voffB[2];
#pragma unroll
    for (int i = 0; i < 2; ++i) { int R, C; stage_rc(tid * 16 + i * 8192, R, C); const int Rb = Epi::PERM ? ((R & ~31) + perm32(R & 31)) : R;
        voffA[i] = (unsigned)(R * K + C) * 2u; voffB[i] = (unsigned)(Rb * K + C) * 2u; }
    const size_t kstep = (size_t)(BK * 2);
    const size_t hstep = (size_t)HALF * K * 2;
    const size_t tstep = 2 * hstep;
    const unsigned ldsw = (unsigned)wid * 1024u;
    const int aoff = lds_byte(wr * 64 + fr, fq * 8), boff = lds_byte(wc * 32 + fr, fq * 8);
#define PG8_SA(b, h) (((b) * 2 + (h)) * HTB)
#define PG8_SB(b, h) ((4 + (b) * 2 + (h)) * HTB)
#define PG8_STAGE(bufoff, gbase, voff) do { _Pragma("unroll") for (int _i = 0; _i < 2; ++_i) \
        __builtin_amdgcn_global_load_lds((const unsigned*)((const char*)(gbase) + (voff)[_i]), (PG8_LAS unsigned*)(lds + (bufoff) + ldsw + _i * 8192), 16, 0, 0); } while (0)
#define PG8_LDA(dst, b, h) do { _Pragma("unroll") for (int m = 0; m < 4; ++m) _Pragma("unroll") for (int k = 0; k < 2; ++k) dst[m][k] = *(const PG8_LAS bf16x8*)(lds + PG8_SA(b, h) + aoff + m * 2048 + k * 1024); } while (0)
#define PG8_LDB(dst, b, h) do { _Pragma("unroll") for (int n = 0; n < 2; ++n) _Pragma("unroll") for (int k = 0; k < 2; ++k) dst[n][k] = *(const PG8_LAS bf16x8*)(lds + PG8_SB(b, h) + boff + n * 2048 + k * 1024); } while (0)
#define PG8_MMA(ai, bj, At, Bt) do { __builtin_amdgcn_s_setprio(1); _Pragma("unroll") for (int m = 0; m < 4; ++m) _Pragma("unroll") for (int n = 0; n < 2; ++n) _Pragma("unroll") for (int k = 0; k < 2; ++k) \
        acc[ai][bj][m][n] = __builtin_amdgcn_mfma_f32_16x16x32_bf16(Bt[n][k], At[m][k], acc[ai][bj][m][n], 0, 0, 0); __builtin_amdgcn_s_setprio(0); } while (0)
#define PG8_WAIT_V(n) asm volatile("s_waitcnt vmcnt(" #n ")" ::: "memory")
#define PG8_WAIT_L(n) asm volatile("s_waitcnt lgkmcnt(" #n ")" ::: "memory")
#define PG8_BAR __builtin_amdgcn_s_barrier()
#define PG8_SCHED __builtin_amdgcn_sched_barrier(0)
    Unit cur, nxt; int ui = 0;
    if (!S.next(0, cur)) return;
    f32x4 acc[2][2][4][2];
#pragma unroll
    for (int a = 0; a < 2; ++a)
#pragma unroll
        for (int b = 0; b < 2; ++b)
#pragma unroll
            for (int m = 0; m < 4; ++m)
#pragma unroll
                for (int n = 0; n < 2; ++n) acc[a][b][m][n] = (f32x4){0.f, 0.f, 0.f, 0.f};
    bf16x8 At[4][2], B0[2][2], B1[2][2];
    const char* cA = (const char*)g.A + (size_t)cur.pm * tstep; const char* cB = (const char*)g.Bt + (size_t)cur.pn * tstep;
    S.a_ready(cur);
    if constexpr (SP2) {
        PG8_STAGE(PG8_SB(0, 0), cB, voffB); PG8_STAGE(PG8_SB(0, 1), cB + hstep, voffB); PG8_STAGE(PG8_SA(0, 0), cA, voffA); PG8_STAGE(PG8_SA(0, 1), cA + hstep, voffA);
        if (wr == 1) PG8_BAR;
        PG8_WAIT_V(2); PG8_BAR;
        PG8_STAGE(PG8_SB(1, 0), cB + kstep, voffB); PG8_STAGE(PG8_SA(1, 0), cA + kstep, voffA); PG8_STAGE(PG8_SB(1, 1), cB + hstep + kstep, voffB);
        PG8_WAIT_V(6); PG8_BAR;
    } else {
        PG8_STAGE(PG8_SB(0, 0), cB, voffB); PG8_STAGE(PG8_SA(0, 0), cA, voffA); PG8_STAGE(PG8_SB(0, 1), cB + hstep, voffB); PG8_STAGE(PG8_SA(0, 1), cA + hstep, voffA);
        if (wr == 1) PG8_BAR;
        PG8_WAIT_V(4); PG8_BAR;
        PG8_STAGE(PG8_SB(1, 0), cB + kstep, voffB); PG8_STAGE(PG8_SA(1, 0), cA + kstep, voffA); PG8_STAGE(PG8_SB(1, 1), cB + hstep + kstep, voffB);
        PG8_WAIT_V(6); PG8_BAR;
    }
    for (;;) {
        const bool has_next = S.next(ui + 1, nxt);
        const char* nA = has_next ? (const char*)g.A + (size_t)nxt.pm * tstep : cA; const char* nB = has_next ? (const char*)g.Bt + (size_t)nxt.pn * tstep : cB;
        for (int t = 0; t < nt; t += 2) {
            const bool last = (t == nt - 2);
            const char* a1 = cA + (size_t)(t + 1) * kstep;
            const char* a2 = last ? nA : cA + (size_t)(t + 2) * kstep; const char* b2 = last ? nB : cB + (size_t)(t + 2) * kstep;
            const char* a3 = a2 + kstep; const char* b3 = b2 + kstep;
            if (last && has_next) S.a_ready(nxt);
            if constexpr (SP2) {
            PG8_LDB(B0, 0, 0); PG8_LDB(B1, 0, 1); PG8_SCHED; PG8_LDA(At, 0, 0); PG8_STAGE(PG8_SA(1, 1), a1 + hstep, voffA);
            PG8_WAIT_V(8); PG8_WAIT_L(0); PG8_BAR; PG8_MMA(0, 0, At, B0); PG8_MMA(0, 1, At, B1); PG8_BAR; PG8_SCHED;
            PG8_LDA(At, 0, 1); PG8_STAGE(PG8_SB(0, 0), b2, voffB); PG8_STAGE(PG8_SB(0, 1), b2 + hstep, voffB); PG8_STAGE(PG8_SA(0, 0), a2, voffA);
            PG8_WAIT_V(8); PG8_WAIT_L(0); PG8_BAR; PG8_MMA(1, 0, At, B0); PG8_MMA(1, 1, At, B1); PG8_BAR; PG8_SCHED;
            PG8_LDB(B0, 1, 0); PG8_LDB(B1, 1, 1); PG8_SCHED; PG8_LDA(At, 1, 0); PG8_STAGE(PG8_SA(0, 1), a2 + hstep, voffA);
            PG8_WAIT_V(8); PG8_WAIT_L(0); PG8_BAR; PG8_MMA(0, 0, At, B0); PG8_MMA(0, 1, At, B1); PG8_BAR; PG8_SCHED;
            PG8_LDA(At, 1, 1); PG8_STAGE(PG8_SB(1, 0), b3, voffB); PG8_STAGE(PG8_SB(1, 1), b3 + hstep, voffB); PG8_STAGE(PG8_SA(1, 0), a3, voffA);
            PG8_WAIT_V(8); PG8_WAIT_L(0); PG8_BAR; PG8_MMA(1, 0, At, B0); PG8_MMA(1, 1, At, B1); PG8_BAR; PG8_SCHED;
            } else {
            PG8_LDB(B0, 0, 0); PG8_SCHED; PG8_LDA(At, 0, 0); PG8_STAGE(PG8_SA(1, 1), a1 + hstep, voffA);
            PG8_WAIT_L(8); PG8_BAR; PG8_WAIT_L(0); PG8_MMA(0, 0, At, B0); PG8_BAR; PG8_SCHED;
            PG8_LDB(B1, 0, 1); PG8_STAGE(PG8_SB(0, 0), b2, voffB);
            PG8_BAR; PG8_WAIT_L(0); PG8_MMA(0, 1, At, B1); PG8_BAR;
            PG8_LDA(At, 0, 1); PG8_STAGE(PG8_SA(0, 0), a2, voffA);
            PG8_BAR; PG8_WAIT_L(0); PG8_MMA(1, 0, At, B0); PG8_BAR; PG8_SCHED;
            PG8_STAGE(PG8_SB(0, 1), b2 + hstep, voffB);
            PG8_WAIT_V(6); PG8_BAR; PG8_MMA(1, 1, At, B1); PG8_BAR;
            PG8_LDB(B0, 1, 0); PG8_SCHED; PG8_LDA(At, 1, 0); PG8_STAGE(PG8_SA(0, 1), a2 + hstep, voffA);
            PG8_WAIT_L(8); PG8_BAR; PG8_WAIT_L(0); PG8_MMA(0, 0, At, B0); PG8_BAR; PG8_SCHED;
            PG8_LDB(B1, 1, 1); PG8_STAGE(PG8_SB(1, 0), b3, voffB);
            PG8_BAR; PG8_WAIT_L(0); PG8_MMA(0, 1, At, B1); PG8_BAR;
            PG8_LDA(At, 1, 1); PG8_STAGE(PG8_SA(1, 0), a3, voffA);
            PG8_BAR; PG8_WAIT_L(0); PG8_MMA(1, 0, At, B0); PG8_BAR; PG8_SCHED;
            PG8_STAGE(PG8_SB(1, 1), b3 + hstep, voffB);
            PG8_WAIT_V(6); PG8_BAR; PG8_MMA(1, 1, At, B1); PG8_BAR;
            }
        }
        if constexpr (ALIGN_EPI) { if (wr == 0) PG8_BAR; }
        if constexpr (!Epi::AFTER_DRAIN) { E(acc, cur, wr, wc, fr, fq); S.done(cur); }
        if (!has_next) break;
#pragma unroll
        for (int a = 0; a < 2; ++a)
#pragma unroll
            for (int b = 0; b < 2; ++b)
#pragma unroll
                for (int m = 0; m < 4; ++m)
#pragma unroll
                    for (int n = 0; n < 2; ++n) acc[a][b][m][n] = (f32x4){0.f, 0.f, 0.f, 0.f};
        cur = nxt; cA = nA; cB = nB; ++ui;
        if constexpr (ALIGN_EPI) { if (wr == 1) PG8_BAR; }
    }
    PG8_WAIT_V(0);
    if constexpr (!ALIGN_EPI) { if (wr == 0) PG8_BAR; }
    PG8_BAR;
    if constexpr (Epi::AFTER_DRAIN) { E.fused(acc, cur, wr, wc, fr, fq, lds, wid, lane); S.done(cur); }
#undef PG8_SA
#undef PG8_SB
#undef PG8_STAGE
#undef PG8_LDA
#undef PG8_LDB
#undef PG8_MMA
#undef PG8_WAIT_V
#undef PG8_WAIT_L
#undef PG8_BAR
#undef PG8_SCHED
}
}

constexpr int NWAVES = 8;
#ifndef MK_N_LAUNCHES
#define MK_N_LAUNCHES 1
#endif
constexpr int NPH = 12;
constexpr int N_LAUNCHES = MK_N_LAUNCHES;

constexpr int BATCH = 16, SEQ = 2048, DM = 1024, DEPTH = 2, M = BATCH * SEQ;
constexpr int PC = 3976, PCP = 4096, DFF = 2816, NGU = 2 * DFF;
constexpr int C_MQ = 0, C_MK = 256, C_MV = 512, C_MO = 768, C_MGI = 1024, C_MGF = 1028;
constexpr int C_RQ = 1032, C_RK = 1416, C_RV = 1800, C_RG = 2184;
constexpr int C_WR = 2568, C_WK = 2952, C_WV = 3336, C_WWL = 3720, C_WAL = 3784, C_WGL = 3848;
constexpr int WCOLS = 1408;
constexpr int Y_M = 0, Y_R = 256, Y_W = 640;

constexpr size_t MiB = 1u << 20;
constexpr size_t WS_CTL = 0, CTL_ZERO_BYTES = 2 * MiB;
constexpr size_t WS_RSS = 1 * MiB;
constexpr size_t WS_WIN = 2 * MiB, WS_WOUT = 18 * MiB, WS_WGU = 22 * MiB, WS_WDN = 44 * MiB;
constexpr size_t WS_A1 = 56 * MiB;
constexpr size_t WS_A3 = 120 * MiB;
constexpr size_t WS_P = 184 * MiB;
constexpr size_t WS_END = 440 * MiB;
constexpr int CW_BAR = 4096;

constexpr int RING_OFF = 0, RING_BYTES = 131072;
constexpr int LDS_BYTES = 147456;
constexpr int LDSCTL_OFF = LDS_BYTES - 512, MISC_OFF = LDSCTL_OFF + 320;

#define GAS __attribute__((address_space(1)))
#define LAS __attribute__((address_space(3)))
typedef unsigned short bf16;
typedef unsigned v4u __attribute__((ext_vector_type(4)));
typedef float f32x4 __attribute__((ext_vector_type(4)));
typedef short bf16x8 __attribute__((ext_vector_type(8)));
typedef GAS unsigned gu32;
typedef GAS unsigned long long gu64;
#define RLX_AGENT __ATOMIC_RELAXED, __HIP_MEMORY_SCOPE_AGENT
#define LDS_WAIT() asm volatile("s_waitcnt lgkmcnt(0)" ::: "memory")
#define VM_WAIT() asm volatile("s_waitcnt vmcnt(0)" ::: "memory")
__device__ __forceinline__ unsigned long long rt() { return __builtin_amdgcn_s_memrealtime(); }
__device__ __forceinline__ unsigned f2bf(float f) { unsigned u = __builtin_bit_cast(unsigned, f); return (u + 0x7fffu + ((u >> 16) & 1u)) >> 16; }
__device__ __forceinline__ unsigned pk2(float lo, float hi) { return f2bf(lo) | (f2bf(hi) << 16); }
#define XB_TMO      128
#define XB_XCNT(j)  (256  + 64 * (j))
#define XB_XSUB(j)  (1280 + 64 * (j))
#define XB_XGEN(j)  (2304 + 64 * (j))
#define XB_TOP      3328
#define XB_TOPGEN   3392
#define XCD_BAR_WORDS 3456
#define XB_SPIN_CAP (1u << 18)

__device__ __forceinline__ unsigned xb_ld(unsigned* p)              { return __hip_atomic_load(p, __ATOMIC_RELAXED, __HIP_MEMORY_SCOPE_AGENT); }
__device__ __forceinline__ unsigned xb_add(unsigned* p, unsigned v) { return __hip_atomic_fetch_add(p, v, __ATOMIC_RELAXED, __HIP_MEMORY_SCOPE_AGENT); }
__device__ __forceinline__ unsigned xb_xcc_id() { return (unsigned)__builtin_amdgcn_s_getreg((3 << 11) | 20) & 0xFu; }
#define XB_SPIN(cond, bar) do { unsigned _sp = 0; while (cond) { __builtin_amdgcn_s_sleep(1); \
    if ((++_sp & 255u) == 0u) { if (xb_ld(&(bar)[XB_TMO])) break; if (_sp > XB_SPIN_CAP) { atomicAdd(&(bar)[XB_TMO], 1u); break; } } } } while (0)

struct XcdBarrier {
    unsigned* bar; unsigned x;
    volatile LAS unsigned* st;
};

__device__ __forceinline__ XcdBarrier xcd_barrier_post(unsigned* bar, volatile LAS unsigned* st) {
    XcdBarrier b; b.bar = bar; b.x = xb_xcc_id(); b.st = st;
    if (threadIdx.x == 0) (void)xb_add(&bar[XB_XCNT(b.x)], 1u);
    return b;
}
__device__ __forceinline__ void xcd_barrier_complete(unsigned* bar, unsigned x, unsigned& nloc, unsigned& nx) {
    const unsigned G = gridDim.x * gridDim.y * gridDim.z;
    unsigned sum, cnt, mine, sp = 0u;
    for (;;) {
        sum = 0u; cnt = 0u; mine = 0u;
#pragma unroll
        for (unsigned j = 0; j < 16; ++j) { const unsigned c = xb_ld(&bar[XB_XCNT(j)]); sum += c; cnt += (c > 0u) ? 1u : 0u; mine = (j == x) ? c : mine; }
        if (sum == G) break;
        __builtin_amdgcn_s_sleep(1);
        if ((++sp & 255u) == 0u) { if (xb_ld(&bar[XB_TMO])) break; if (sp > XB_SPIN_CAP) { atomicAdd(&bar[XB_TMO], 1u); break; } }
    }
    nloc = mine > 0u ? mine : 1u; nx = cnt > 0u ? cnt : 1u;
}

__device__ __forceinline__ void xcd_barrier(const XcdBarrier& b) {
    asm volatile("s_waitcnt vmcnt(0)" ::: "memory");
    __syncthreads();
    if (threadIdx.x == 0) {
        unsigned* bar = b.bar;
        __builtin_amdgcn_s_waitcnt(0);
        unsigned nloc = b.st[0], nx = b.st[1];
        if (nloc == 0u) { xcd_barrier_complete(bar, b.x, nloc, nx); b.st[0] = nloc; b.st[1] = nx; }
        const unsigned old = xb_add(&bar[XB_XSUB(b.x)], 1u);
        const unsigned gen = old / nloc;
        if (old + 1u == (gen + 1u) * nloc) {
            __builtin_amdgcn_fence(__ATOMIC_RELEASE, "agent");
            asm volatile("s_waitcnt vmcnt(0)" ::: "memory");
            const unsigned og = xb_add(&bar[XB_TOP], 1u);
            const unsigned tg = og / nx;
            if (og + 1u == (tg + 1u) * nx) xb_add(&bar[XB_TOPGEN], 1u);
            else XB_SPIN(xb_ld(&bar[XB_TOPGEN]) == tg, bar);
            __builtin_amdgcn_fence(__ATOMIC_ACQUIRE, "agent");
            xb_add(&bar[XB_XGEN(b.x)], 1u);
            asm volatile("s_waitcnt vmcnt(0)" ::: "memory");
        } else {
            XB_SPIN(xb_ld(&bar[XB_XGEN(b.x)]) == gen, bar);
            __builtin_amdgcn_fence(__ATOMIC_ACQUIRE, "agent");
            asm volatile("s_waitcnt vmcnt(0)" ::: "memory");
        }
    }
    __syncthreads();
}

struct Frame {
    LAS unsigned char* lds;
    volatile LAS unsigned* MISC;
    gu32* ctl;
    int tid, lane, wave;
    int vcu, G;
    float* out; unsigned char* ws;
};
struct Args { const float* in[24]; float* out; unsigned char* ws; int ph_lo, ph_hi, li, pad; };
__device__ __forceinline__ float wave_sum(float v) {
#pragma unroll
    for (int o = 1; o < 64; o <<= 1) v += __shfl_xor(v, o);
    return v;
}
template <int CTRL> __device__ __forceinline__ float dpp_mov(float x) { return __builtin_bit_cast(float, __builtin_amdgcn_update_dpp(0, __builtin_bit_cast(int, x), CTRL, 0xf, 0xf, true)); }
__device__ __forceinline__ float red8(float x) { x += dpp_mov<0x141>(x); x += dpp_mov<0xB1>(x); x += dpp_mov<0x4E>(x); return x; }
__device__ __forceinline__ float bflo(unsigned w) { return __builtin_bit_cast(float, w << 16); }
__device__ __forceinline__ float bfhi(unsigned w) { return __builtin_bit_cast(float, w & 0xffff0000u); }
__device__ __forceinline__ void ld8g(const bf16* p, float (&v)[8]) { const v4u w = *(const v4u*)p;
    v[0] = bflo(w.x); v[1] = bfhi(w.x); v[2] = bflo(w.y); v[3] = bfhi(w.y); v[4] = bflo(w.z); v[5] = bfhi(w.z); v[6] = bflo(w.w); v[7] = bfhi(w.w); }
__device__ __forceinline__ void ld8l(const LAS bf16* p, float (&v)[8]) { const v4u w = *(const LAS v4u*)p;
    v[0] = bflo(w.x); v[1] = bfhi(w.x); v[2] = bflo(w.y); v[3] = bfhi(w.y); v[4] = bflo(w.z); v[5] = bfhi(w.z); v[6] = bflo(w.w); v[7] = bfhi(w.w); }
__device__ __forceinline__ void ld8f(const float* p, float (&v)[8]) { const f32x4 a = *(const f32x4*)p, b = *(const f32x4*)(p + 4);
    v[0] = a.x; v[1] = a.y; v[2] = a.z; v[3] = a.w; v[4] = b.x; v[5] = b.y; v[6] = b.z; v[7] = b.w; }
__device__ __forceinline__ void ld8lf(const LAS float* p, float (&v)[8]) { const f32x4 a = *(const LAS f32x4*)p, b = *(const LAS f32x4*)(p + 4);
    v[0] = a.x; v[1] = a.y; v[2] = a.z; v[3] = a.w; v[4] = b.x; v[5] = b.y; v[6] = b.z; v[7] = b.w; }
__device__ __forceinline__ void st8lf(LAS float* p, const float (&v)[8]) { *(LAS f32x4*)p = (f32x4){v[0], v[1], v[2], v[3]}; *(LAS f32x4*)(p + 4) = (f32x4){v[4], v[5], v[6], v[7]}; }
__device__ __forceinline__ v4u pack8(const float (&v)[8]) { v4u w; w.x = pk2(v[0], v[1]); w.y = pk2(v[2], v[3]); w.z = pk2(v[4], v[5]); w.w = pk2(v[6], v[7]); return w; }
__device__ __forceinline__ float sigmoid_f(float x) { return __builtin_amdgcn_rcpf(1.0f + __expf(-x)); }
__device__ __forceinline__ float silu2_f(float x) { return x * sigmoid_f(x); }
__device__ __forceinline__ float softplus_f(float z) { return fmaxf(z, 0.f) + log1pf(__expf(-fabsf(z))); }
__device__ __forceinline__ float tanh_f(float x) { return 1.0f - 2.0f * __builtin_amdgcn_rcpf(1.0f + __expf(2.0f * x)); }

__device__ __forceinline__ void p0_transpose_item(const float* W, int K, int N, bf16* WT, int mode, LAS float* scr, int kb, int nb, int lane) {
    const int k0 = 64 * kb, n0 = 32 * nb;
    const int nn = n0 + (lane & 31);
#pragma unroll 8
    for (int i = 0; i < 32; ++i) { const int kk = 2 * i + (lane >> 5); scr[kk * 33 + (lane & 31)] = (nn < N) ? W[(size_t)(k0 + kk) * N + nn] : 0.f; }
    LDS_WAIT(); asm volatile("" ::: "memory");
    const int c = lane & 7;
#pragma unroll
    for (int j = 0; j < 4; ++j) { const int n = (lane >> 3) + 8 * j; const LAS float* s = scr + (8 * c) * 33 + n;
        v4u o; o.x = pk2(s[0 * 33], s[1 * 33]); o.y = pk2(s[2 * 33], s[3 * 33]); o.z = pk2(s[4 * 33], s[5 * 33]); o.w = pk2(s[6 * 33], s[7 * 33]);
        const int ng = n0 + n; const int drow = (mode == 0) ? ng : ((ng >> 7) * 256 + (ng & 127) + (mode == 2 ? 128 : 0));
        *(GAS v4u*)(WT + (size_t)drow * K + k0 + 8 * c) = o; }
    LDS_WAIT(); asm volatile("" ::: "memory");
}
__device__ __forceinline__ void p0_prologue(Frame& F, const Args& A) {
    LAS float* scr = (LAS float*)(F.lds + RING_OFF + F.wave * 16384);
    const int gw = F.vcu * NWAVES + F.wave, NGW = F.G * NWAVES;
    constexpr int I_IN = 16 * 128, I_OUT = 16 * 32, I_G = 16 * 88, I_D = 44 * 32, I_L = I_IN + I_OUT + 2 * I_G + I_D;
    for (int it = gw; it < DEPTH * I_L; it += NGW) {
        const int l = it / I_L; int r = it % I_L;
        if (r < I_IN) { p0_transpose_item(A.in[1] + (size_t)l * DM * PC, DM, PC, (bf16*)(F.ws + WS_WIN) + (size_t)l * PCP * DM, 0, scr, r / 128, r % 128, F.lane); continue; } r -= I_IN;
        if (r < I_OUT) { p0_transpose_item(A.in[20] + (size_t)l * DM * DM, DM, DM, (bf16*)(F.ws + WS_WOUT) + (size_t)l * DM * DM, 0, scr, r / 32, r % 32, F.lane); continue; } r -= I_OUT;
        if (r < I_G) { p0_transpose_item(A.in[21] + (size_t)l * DM * DFF, DM, DFF, (bf16*)(F.ws + WS_WGU) + (size_t)l * NGU * DM, 1, scr, r / 88, r % 88, F.lane); continue; } r -= I_G;
        if (r < I_G) { p0_transpose_item(A.in[22] + (size_t)l * DM * DFF, DM, DFF, (bf16*)(F.ws + WS_WGU) + (size_t)l * NGU * DM, 2, scr, r / 88, r % 88, F.lane); continue; } r -= I_G;
        p0_transpose_item(A.in[23] + (size_t)l * DFF * DM, DFF, DM, (bf16*)(F.ws + WS_WDN) + (size_t)l * DM * DFF, 0, scr, r / 32, r % 32, F.lane);
    }
    const float* x = A.in[0]; const float* g1 = A.in[2]; bf16* xn = (bf16*)(F.ws + WS_A1); float* rss = (float*)(F.ws + WS_RSS);
    f32x4 gv[4];
#pragma unroll
    for (int j = 0; j < 4; ++j) gv[j] = ((const f32x4*)g1)[F.lane + 64 * j];
    for (int m = gw; m < M; m += NGW) {
        const GAS f32x4* xr = (const GAS f32x4*)(x + (size_t)m * DM) + F.lane; GAS unsigned long long* o8 = (GAS unsigned long long*)(xn + (size_t)m * DM) + F.lane;
        f32x4 v[4]; float s = 0.f;
#pragma unroll
        for (int j = 0; j < 4; ++j) { v[j] = xr[64 * j]; s += (v[j].x * v[j].x + v[j].y * v[j].y) + (v[j].z * v[j].z + v[j].w * v[j].w); }
        s = wave_sum(s);
#pragma unroll
        for (int j = 0; j < 4; ++j) { const f32x4 w = v[j] * gv[j]; o8[64 * j] = (unsigned long long)pk2(w.x, w.y) | ((unsigned long long)pk2(w.z, w.w) << 32); }
        if (F.lane == 0) rss[m] = s;
    }
}
__device__ __forceinline__ void final_norm(Frame& F, const Args& A) {
    const int gw = F.vcu * NWAVES + F.wave, NGW = F.G * NWAVES; const float* gf = A.in[4];
    f32x4 gv[4];
#pragma unroll
    for (int j = 0; j < 4; ++j) gv[j] = ((const f32x4*)gf)[F.lane + 64 * j];
    for (int m = gw; m < M; m += NGW) {
        GAS f32x4* xr = (GAS f32x4*)(F.out + (size_t)m * DM) + F.lane;
        f32x4 v[4]; float s = 0.f;
#pragma unroll
        for (int j = 0; j < 4; ++j) { v[j] = xr[64 * j]; s += (v[j].x * v[j].x + v[j].y * v[j].y) + (v[j].z * v[j].z + v[j].w * v[j].w); }
        const float rs = 1.0f / sqrtf(wave_sum(s) * (1.0f / DM) + 1e-6f);
#pragma unroll
        for (int j = 0; j < 4; ++j) xr[64 * j] = v[j] * rs * gv[j];
    }
}

__device__ __forceinline__ void ret_unit(Frame& F, int b, int h) {
    LAS float* Q = (LAS float*)F.lds; LAS float* K = Q + 4096; LAS float* V = K + 4096; LAS float* Y = V + 4096;
    const bf16* P = (const bf16*)(F.ws + WS_P); bf16* Yg = (bf16*)(F.ws + WS_A1);
    int tid_ = F.tid; asm volatile("" : "+v"(tid_)); const int tid = tid_, tok = tid >> 3, cs = tid & 7;
    const float gamma = 1.0f - exp2f(-5.0f - (float)h);
    float S[8];
#pragma unroll
    for (int j = 0; j < 8; ++j) S[j] = 0.f;
    for (int c = 0; c < SEQ / 64; ++c) {
        const int t = c * 64 + tok; const size_t row = (size_t)b * SEQ + t; const bf16* prow = P + row * PCP;
        {
            const int i0 = 8 * (cs & 3);
            float q1[8], q2[8], k1[8], k2[8], vv[8], qo[8], ko[8];
            ld8g(prow + C_RQ + 64 * h + i0, q1); ld8g(prow + C_RQ + 64 * h + 32 + i0, q2);
            ld8g(prow + C_RK + 64 * h + i0, k1); ld8g(prow + C_RK + 64 * h + 32 + i0, k2);
            ld8g(prow + C_RV + 64 * h + 8 * cs, vv);
#pragma unroll
            for (int j = 0; j < 8; ++j) {
                const float theta = exp2f(-(float)(i0 + j) * (13.287712379549449f / 31.0f));
                float rev = (float)t * theta * 0.15915494309189535f; rev -= floorf(rev);
                const float sn = __builtin_amdgcn_sinf(rev), cn = __builtin_amdgcn_cosf(rev);
                if (cs < 4) { qo[j] = q1[j] * cn - q2[j] * sn; ko[j] = k1[j] * cn - k2[j] * sn; }
                else        { qo[j] = q1[j] * sn + q2[j] * cn; ko[j] = k1[j] * sn + k2[j] * cn; }
                ko[j] *= 0.125f;
            }
            st8lf(Q + tok * 64 + 8 * cs, qo); st8lf(K + tok * 64 + 8 * cs, ko); st8lf(V + tok * 64 + 8 * cs, vv);
        }
        __syncthreads();
        {
            const int e = tok, ds = cs;
            for (int tt = 0; tt < 64; ++tt) {
                float kv[8], qv[8]; ld8lf(K + tt * 64 + 8 * ds, kv); ld8lf(Q + tt * 64 + 8 * ds, qv); const float ve = V[tt * 64 + e];
                float acc = 0.f;
#pragma unroll
                for (int j = 0; j < 8; ++j) { S[j] = gamma * S[j] + kv[j] * ve; acc += qv[j] * S[j]; }
                acc = red8(acc);
                if (ds == 0) Y[tt * 64 + e] = acc;
            }
        }
        __syncthreads();
        {
            float y[8], g[8], o[8]; ld8lf(Y + tok * 64 + 8 * cs, y); ld8g(prow + C_RG + 64 * h + 8 * cs, g);
            float s1 = 0.f;
#pragma unroll
            for (int j = 0; j < 8; ++j) s1 += y[j];
            const float mu = red8(s1) * (1.0f / 64.0f); float s2 = 0.f;
#pragma unroll
            for (int j = 0; j < 8; ++j) { y[j] -= mu; s2 += y[j] * y[j]; }
            const float rstd = 1.0f / sqrtf(red8(s2) * (1.0f / 64.0f) + 1e-5f);
#pragma unroll
            for (int j = 0; j < 8; ++j) o[j] = silu2_f(g[j]) * y[j] * rstd;
            *(v4u*)(Yg + row * DM + Y_R + 64 * h + 8 * cs) = pack8(o);
        }
    }
    __syncthreads();
}

__device__ __forceinline__ void mlstm_unit(Frame& F, const Args& A, int l, int b, int h) {
    LAS float* Q = (LAS float*)F.lds; LAS float* K = Q + 4096; LAS float* V = K + 4096; LAS float* Hh = V + 4096; LAS float* IG = Hh + 4096; LAS float* LF = IG + 64;
    const bf16* P = (const bf16*)(F.ws + WS_P); bf16* Yg = (bf16*)(F.ws + WS_A1);
    const float* convw = A.in[5] + (size_t)l * 4 * 512; const float bi = A.in[6][l * 4 + h], bfv = A.in[7][l * 4 + h]; const float* lng = A.in[8] + l * 256 + 64 * h;
    int tid_ = F.tid; asm volatile("" : "+v"(tid_)); const int tid = tid_, tok = tid >> 3, cs = tid & 7;
    float C[8], n[8]; float mst = -1e30f;
#pragma unroll
    for (int j = 0; j < 8; ++j) { C[j] = 0.f; n[j] = 0.f; }
    for (int c = 0; c < SEQ / 64; ++c) {
        const int t = c * 64 + tok; const size_t row = (size_t)b * SEQ + t; const bf16* prow = P + row * PCP;
        {
            float aq[8], ak[8], vv[8];
#pragma unroll
            for (int j = 0; j < 8; ++j) { aq[j] = 0.f; ak[j] = 0.f; }
#pragma unroll
            for (int jj = 0; jj < 4; ++jj) { const int tt = t - 3 + jj;
                if (tt >= 0) { const bf16* pr = P + ((size_t)b * SEQ + tt) * PCP; float xq[8], xk[8], wq[8], wk[8];
                    ld8g(pr + C_MQ + 64 * h + 8 * cs, xq); ld8g(pr + C_MK + 64 * h + 8 * cs, xk);
                    ld8f(convw + jj * 512 + 64 * h + 8 * cs, wq); ld8f(convw + jj * 512 + 256 + 64 * h + 8 * cs, wk);
#pragma unroll
                    for (int j = 0; j < 8; ++j) { aq[j] += wq[j] * xq[j]; ak[j] += wk[j] * xk[j]; } } }
#pragma unroll
            for (int j = 0; j < 8; ++j) { aq[j] = silu2_f(aq[j]); ak[j] = silu2_f(ak[j]) * 0.125f; }
            ld8g(prow + C_MV + 64 * h + 8 * cs, vv);
            st8lf(Q + tok * 64 + 8 * cs, aq); st8lf(K + tok * 64 + 8 * cs, ak); st8lf(V + tok * 64 + 8 * cs, vv);
            if (cs == 0) { const float gi = bflo((unsigned)prow[C_MGI + h]) + bi; const float xf = bflo((unsigned)prow[C_MGF + h]) + bfv;
                IG[tok] = gi; LF[tok] = fminf(xf, 0.f) - log1pf(__expf(-fabsf(xf))); }
        }
        __syncthreads();
        {
            const int e = tok, ds = cs;
            for (int tt = 0; tt < 64; ++tt) {
                const float lf = LF[tt], ig = IG[tt]; const float mn = fmaxf(lf + mst, ig); const float fd = __expf(lf + mst - mn), iw = __expf(ig - mn);
                float kv[8], qv[8]; ld8lf(K + tt * 64 + 8 * ds, kv); ld8lf(Q + tt * 64 + 8 * ds, qv); const float ve = V[tt * 64 + e];
                float num = 0.f, den = 0.f;
#pragma unroll
                for (int j = 0; j < 8; ++j) { const float ik = iw * kv[j]; C[j] = fd * C[j] + ik * ve; n[j] = fd * n[j] + ik; num += qv[j] * C[j]; den += qv[j] * n[j]; }
                num = red8(num); den = red8(den);
                if (ds == 0) Hh[tt * 64 + e] = num / fmaxf(fabsf(den), __expf(-mn));
                mst = mn;
            }
        }
        __syncthreads();
        {
            float y[8], og[8], gl[8], o[8]; ld8lf(Hh + tok * 64 + 8 * cs, y); ld8g(prow + C_MO + 64 * h + 8 * cs, og); ld8f(lng + 8 * cs, gl);
            float s1 = 0.f;
#pragma unroll
            for (int j = 0; j < 8; ++j) s1 += y[j];
            const float mu = red8(s1) * (1.0f / 64.0f); float s2 = 0.f;
#pragma unroll
            for (int j = 0; j < 8; ++j) { y[j] -= mu; s2 += y[j] * y[j]; }
            const float rstd = 1.0f / sqrtf(red8(s2) * (1.0f / 64.0f) + 1e-5f);
#pragma unroll
            for (int j = 0; j < 8; ++j) o[j] = sigmoid_f(og[j]) * y[j] * rstd * gl[j];
            *(v4u*)(Yg + row * DM + Y_M + 64 * h + 8 * cs) = pack8(o);
        }
    }
    __syncthreads();
}

constexpr int XW_LD = 72, XG_LD = 136;
__device__ __forceinline__ void rwkv_shift8(const bf16* prow, bool has_prev, int col, const float* mu, float (&o)[8]) {
    float cur[8], prv[8], m8[8]; ld8g(prow + col, cur);
    if (has_prev) ld8g(prow - PCP + col, prv); else {
#pragma unroll
        for (int j = 0; j < 8; ++j) prv[j] = 0.f; }
    ld8f(mu + (col - C_WR), m8);
#pragma unroll
    for (int j = 0; j < 8; ++j) o[j] = cur[j] + m8[j] * (prv[j] - cur[j]);
}
__device__ __forceinline__ void rwkv_unit(Frame& F, const Args& A, int l, int b, int h) {
    LAS float* R = (LAS float*)F.lds; LAS float* Wd = R + 4096; LAS float* KP = Wd + 4096; LAS float* KK = KP + 4096; LAS float* KA = KK + 4096; LAS float* V = KA + 4096;
    LAS bf16* XW = (LAS bf16*)(F.lds + 98304); LAS bf16* XA = XW + 64 * XW_LD; LAS bf16* XG = XA + 64 * XW_LD;
    LAS float* Yl = (LAS float*)(F.lds + 98304);
    const bf16* P = (const bf16*)(F.ws + WS_P); bf16* Yg = (bf16*)(F.ws + WS_A1);
    const float* mu = A.in[9] + (size_t)l * WCOLS; const float* w0 = A.in[10] + l * 384 + 64 * h; const float* wup = A.in[11] + (size_t)l * 64 * 384 + 64 * h;
    const float* a0 = A.in[12] + l * 384 + 64 * h; const float* aup = A.in[13] + (size_t)l * 64 * 384 + 64 * h; const float* gup = A.in[14] + (size_t)l * 128 * 384 + 64 * h;
    const float* kk_w = A.in[15] + l * 384 + 64 * h; const float* ka_w = A.in[16] + l * 384 + 64 * h; const float* rk_w = A.in[17] + l * 384 + 64 * h;
    const float* lng = A.in[18] + l * 384 + 64 * h; const float* lnb = A.in[19] + l * 384 + 64 * h;
    int tid_ = F.tid; asm volatile("" : "+v"(tid_)); const int tid = tid_, tok = tid >> 3, cs = tid & 7;
    float S[8];
#pragma unroll
    for (int j = 0; j < 8; ++j) S[j] = 0.f;
    for (int c = 0; c < SEQ / 64; ++c) {
        const int t = c * 64 + tok; const size_t row = (size_t)b * SEQ + t; const bf16* prow = P + row * PCP; const bool hp = t > 0;
        {
            float x[8], y[8];
            rwkv_shift8(prow, hp, C_WWL + 8 * cs, mu, x);
#pragma unroll
            for (int j = 0; j < 8; ++j) y[j] = tanh_f(x[j]);
            *(LAS v4u*)(XW + tok * XW_LD + 8 * cs) = pack8(y);
            rwkv_shift8(prow, hp, C_WAL + 8 * cs, mu, x);
            *(LAS v4u*)(XA + tok * XW_LD + 8 * cs) = pack8(x);
#pragma unroll
            for (int q = 0; q < 2; ++q) { rwkv_shift8(prow, hp, C_WGL + 16 * cs + 8 * q, mu, x);
#pragma unroll
                for (int j = 0; j < 8; ++j) y[j] = sigmoid_f(x[j]);
                *(LAS v4u*)(XG + tok * XG_LD + 16 * cs + 8 * q) = pack8(y); }
        }
        __syncthreads();
        float g8[8];
        {
            float wacc[8], aacc[8];
            ld8f(w0 + 8 * cs, wacc); ld8f(a0 + 8 * cs, aacc);
#pragma unroll
            for (int j = 0; j < 8; ++j) g8[j] = 0.f;
#pragma unroll 2
            for (int jj = 0; jj < 64; ++jj) { const float xw = bflo((unsigned)XW[tok * XW_LD + jj]), xa = bflo((unsigned)XA[tok * XW_LD + jj]); float u[8], v[8];
                ld8f(wup + (size_t)jj * 384 + 8 * cs, u); ld8f(aup + (size_t)jj * 384 + 8 * cs, v);
#pragma unroll
                for (int j = 0; j < 8; ++j) { wacc[j] += xw * u[j]; aacc[j] += xa * v[j]; } }
#pragma unroll 2
            for (int jj = 0; jj < 128; ++jj) { const float xg = bflo((unsigned)XG[tok * XG_LD + jj]); float u[8]; ld8f(gup + (size_t)jj * 384 + 8 * cs, u);
#pragma unroll
                for (int j = 0; j < 8; ++j) g8[j] += xg * u[j]; }
            float r8[8], k8[8], v8[8], kkw[8], kaw[8], dec[8], kk[8], ka[8], kp[8];
            rwkv_shift8(prow, hp, C_WR + 64 * h + 8 * cs, mu, r8); rwkv_shift8(prow, hp, C_WK + 64 * h + 8 * cs, mu, k8); rwkv_shift8(prow, hp, C_WV + 64 * h + 8 * cs, mu, v8);
            ld8f(kk_w + 8 * cs, kkw); ld8f(ka_w + 8 * cs, kaw);
            float ss = 0.f;
#pragma unroll
            for (int j = 0; j < 8; ++j) { const float wl = -softplus_f(-wacc[j]) - 0.5f; dec[j] = __expf(-__expf(wl)); const float a = sigmoid_f(aacc[j]);
                kk[j] = k8[j] * kkw[j]; ss += kk[j] * kk[j]; kp[j] = k8[j] * (1.0f + (a - 1.0f) * kaw[j]); ka[j] = a; }
            ss = red8(ss); const float inv = 1.0f / fmaxf(sqrtf(ss), 1e-12f);
#pragma unroll
            for (int j = 0; j < 8; ++j) { kk[j] *= inv; ka[j] *= kk[j]; }
            st8lf(R + tok * 64 + 8 * cs, r8); st8lf(Wd + tok * 64 + 8 * cs, dec); st8lf(KP + tok * 64 + 8 * cs, kp); st8lf(KK + tok * 64 + 8 * cs, kk); st8lf(KA + tok * 64 + 8 * cs, ka); st8lf(V + tok * 64 + 8 * cs, v8);
        }
        __syncthreads();
        {
            const int vr = tok, ks = cs;
            for (int tt = 0; tt < 64; ++tt) {
                float kk[8], ka[8], w[8], kp[8], r[8]; ld8lf(KK + tt * 64 + 8 * ks, kk); ld8lf(KA + tt * 64 + 8 * ks, ka); ld8lf(Wd + tt * 64 + 8 * ks, w); ld8lf(KP + tt * 64 + 8 * ks, kp); ld8lf(R + tt * 64 + 8 * ks, r);
                const float vv = V[tt * 64 + vr];
                float sa = 0.f;
#pragma unroll
                for (int j = 0; j < 8; ++j) sa += S[j] * kk[j];
                sa = red8(sa);
                float y = 0.f;
#pragma unroll
                for (int j = 0; j < 8; ++j) { S[j] = S[j] * w[j] - sa * ka[j] + vv * kp[j]; y += S[j] * r[j]; }
                y = red8(y);
                if (ks == 0) Yl[tt * 64 + vr] = y;
            }
        }
        __syncthreads();
        {
            float y[8], r8[8], kp[8], v8[8], rk[8], lg[8], lb[8], o[8];
            ld8lf(Yl + tok * 64 + 8 * cs, y); ld8lf(R + tok * 64 + 8 * cs, r8); ld8lf(KP + tok * 64 + 8 * cs, kp); ld8lf(V + tok * 64 + 8 * cs, v8);
            ld8f(rk_w + 8 * cs, rk); ld8f(lng + 8 * cs, lg); ld8f(lnb + 8 * cs, lb);
            float s1 = 0.f, bs = 0.f;
#pragma unroll
            for (int j = 0; j < 8; ++j) { s1 += y[j]; bs += r8[j] * kp[j] * rk[j]; }
            const float mu_ = red8(s1) * (1.0f / 64.0f); bs = red8(bs); float s2 = 0.f;
#pragma unroll
            for (int j = 0; j < 8; ++j) { y[j] -= mu_; s2 += y[j] * y[j]; }
            const float rstd = 1.0f / sqrtf(red8(s2) * (1.0f / 64.0f) + 64e-5f);
#pragma unroll
            for (int j = 0; j < 8; ++j) o[j] = (y[j] * rstd * lg[j] + lb[j] + bs * v8[j]) * g8[j];
            *(v4u*)(Yg + row * DM + Y_W + 64 * h + 8 * cs) = pack8(o);
        }
        __syncthreads();
    }
}
__device__ __forceinline__ void mixer_phase(Frame& F, const Args& A, int l) {
    for (int u = F.vcu; u < 256; u += F.G) {
        if (u < 96) rwkv_unit(F, A, l, u / 6, u % 6);
        else if (u < 192) ret_unit(F, (u - 96) / 6, (u - 96) % 6);
        else mlstm_unit(F, A, l, (u - 192) / 4, (u - 192) % 4);
    }
}

#ifndef GSEL
#define GSEL 15
#endif
__global__ void __launch_bounds__(NWAVES * 64, 2) hyb_fwd(Args args) {
    extern __shared__ __attribute__((aligned(16))) unsigned char lds[];
    Frame F;
    F.lds = (LAS unsigned char*)lds;
    F.MISC = (volatile LAS unsigned*)(F.lds + MISC_OFF);
    F.tid = threadIdx.x; F.lane = F.tid & 63; F.wave = __builtin_amdgcn_readfirstlane(F.tid >> 6);
    F.G = gridDim.x; { const int bx = blockIdx.x; F.vcu = (F.G % 8 == 0) ? (bx % 8) * (F.G / 8) + bx / 8 : bx; }
    F.ws = args.ws; F.out = args.out; F.ctl = (gu32*)(args.ws + WS_CTL);
    for (int u = F.tid; u < (LDS_BYTES - LDSCTL_OFF) / 4; u += NWAVES * 64) ((LAS unsigned*)(F.lds + LDSCTL_OFF))[u] = 0u;
    __syncthreads();
    XcdBarrier bar; bar.bar = (unsigned*)(F.ctl + CW_BAR); bar.x = 0; bar.st = nullptr;
    if (N_LAUNCHES == 1) bar = xcd_barrier_post((unsigned*)(F.ctl + CW_BAR), F.MISC + 8);
#define GRID_BAR() do { if (N_LAUNCHES == 1) xcd_barrier(bar); } while (0)
    const int lo = args.ph_lo, hi = args.ph_hi;
#define IN(k) (lo <= (k) && (k) < hi)
#define BOTH(k) (IN(k) && IN((k) + 1))
    float* rss = (float*)(args.ws + WS_RSS);
    bf16* A1 = (bf16*)(args.ws + WS_A1); bf16* A3 = (bf16*)(args.ws + WS_A3); bf16* PB = (bf16*)(args.ws + WS_P);

#ifndef SKIP_P0
    if (IN(0)) { p0_prologue(F, args); if (BOTH(0)) GRID_BAR(); }
#endif
    for (int l = 0; l < DEPTH; ++l) {
        const int pb = 1 + 5 * l;
        if (IN(pb) && (GSEL & 1)) {
            pg8::Gemm g{A1, (const bf16*)(args.ws + WS_WIN) + (size_t)l * PCP * DM, M, PCP, DM}; pg8::StaticOrder S; S.init(M, PCP, F.G, (int)blockIdx.x);
            pg8::EpiP E{PB, PCP, rss + (size_t)(2 * l) * M};
            pg8::gemm_phase<pg8::EpiP, pg8::StaticOrder, true, true>(F.lds + RING_OFF, g, S, E);
            if (BOTH(pb)) GRID_BAR();
        }
#ifndef SKIP_MIX
        if (IN(pb + 1)) { mixer_phase(F, args, l); if (BOTH(pb + 1)) GRID_BAR(); }
#endif
        if (IN(pb + 2) && (GSEL & 2)) {
            pg8::Gemm g{A1, (const bf16*)(args.ws + WS_WOUT) + (size_t)l * DM * DM, M, DM, DM}; pg8::StaticOrder S; S.init(M, DM, F.G, (int)blockIdx.x);
            pg8::EpiRes<true> E{l == 0 ? args.in[0] : F.out, F.out, A3, args.in[3] + l * DM, rss + (size_t)(2 * l + 1) * M, DM};
            pg8::gemm_phase<pg8::EpiRes<true>, pg8::StaticOrder, true, true>(F.lds + RING_OFF, g, S, E);
            if (BOTH(pb + 2)) GRID_BAR();
        }
        if (IN(pb + 3) && (GSEL & 4)) {
            pg8::Gemm g{A3, (const bf16*)(args.ws + WS_WGU) + (size_t)l * NGU * DM, M, NGU, DM}; pg8::StaticOrder S; S.init(M, NGU, F.G, (int)blockIdx.x);
            pg8::EpiSwiGLU E{PB, DFF, rss + (size_t)(2 * l + 1) * M};
            pg8::gemm_phase<pg8::EpiSwiGLU, pg8::StaticOrder, true, true>(F.lds + RING_OFF, g, S, E);
            if (BOTH(pb + 3)) GRID_BAR();
        }
        if (IN(pb + 4) && (GSEL & 8)) {
            pg8::Gemm g{PB, (const bf16*)(args.ws + WS_WDN) + (size_t)l * DM * DFF, M, DM, DFF}; pg8::StaticOrder S; S.init(M, DM, F.G, (int)blockIdx.x);
            if (l + 1 < DEPTH) { pg8::EpiRes<true> E{F.out, F.out, A1, args.in[2] + (l + 1) * DM, rss + (size_t)(2 * l + 2) * M, DM};
                pg8::gemm_phase<pg8::EpiRes<true>, pg8::StaticOrder, true, true>(F.lds + RING_OFF, g, S, E); }
            else { pg8::EpiRes<false> E{F.out, F.out, nullptr, nullptr, nullptr, DM};
                pg8::gemm_phase<pg8::EpiRes<false>, pg8::StaticOrder, true, true>(F.lds + RING_OFF, g, S, E); }
            if (BOTH(pb + 4)) GRID_BAR();
        }
    }
    if (IN(NPH - 1)) final_norm(F, args);
#undef IN
#undef BOTH
}

extern "C" void kernel_launch(void* const* d_in, const int* in_sizes, int n_in, void* d_out, int out_size, void* d_ws, size_t ws_size, hipStream_t stream) {
    static int grid = 0;
    if (grid == 0) {
        if (n_in != 24 || in_sizes[0] != M * DM || out_size != M * DM || ws_size < WS_END) { fprintf(stderr, "kernel_launch: unexpected shapes: n_in %d in0 %d out %d ws %zu (need %zu)\n", n_in, n_in > 0 ? in_sizes[0] : -1, out_size, ws_size, (size_t)WS_END); grid = -1; return; }
        int dev = 0, cus = 0;
        if (hipGetDevice(&dev) != hipSuccess || hipDeviceGetAttribute(&cus, hipDeviceAttributeMultiprocessorCount, dev) != hipSuccess) { grid = -1; return; }
        if (hipFuncSetAttribute((const void*)hyb_fwd, hipFuncAttributeMaxDynamicSharedMemorySize, LDS_BYTES) != hipSuccess) { fprintf(stderr, "kernel_launch: hipFuncSetAttribute failed\n"); grid = -1; return; }
        int per_cu = 0;
        if (hipOccupancyMaxActiveBlocksPerMultiprocessor(&per_cu, (const void*)hyb_fwd, NWAVES * 64, LDS_BYTES) != hipSuccess || per_cu < 1) fprintf(stderr, "kernel_launch: occupancy query says %d\n", per_cu);
        (void)hipGetLastError();
        grid = cus;
    }
    if (grid < 0) return;
    if (hipMemsetAsync((char*)d_ws + WS_CTL, 0, CTL_ZERO_BYTES, stream) != hipSuccess) return;
    Args a{};
    for (int i = 0; i < 24; ++i) a.in[i] = (const float*)d_in[i];
    a.out = (float*)d_out; a.ws = (unsigned char*)d_ws;
    for (int li = 0; li < N_LAUNCHES; ++li) {
        a.ph_lo = (N_LAUNCHES == 1) ? 0 : li; a.ph_hi = (N_LAUNCHES == 1) ? NPH : li + 1; a.li = li;
        hipLaunchKernelGGL(hyb_fwd, dim3(grid), dim3(NWAVES * 64), LDS_BYTES, stream, a);
        if (hipPeekAtLastError() != hipSuccess) { fprintf(stderr, "kernel_launch: launch %d failed\n", li); break; }
    }
}
```

```cpp
#include <hip/hip_runtime.h>
#include <cstdio>
#include <cstdint>
#include <cmath>
#define MK_N_LAUNCHES 1
namespace pg8 {
#define PG8_LAS __attribute__((address_space(3)))
typedef unsigned short bf16_t;
typedef short bf16x8 __attribute__((ext_vector_type(8)));
typedef float f32x4 __attribute__((ext_vector_type(4)));
typedef unsigned u32x4 __attribute__((ext_vector_type(4)));
constexpr int BM = 256, BK = 64, HALF = 128, HTB = HALF * BK * 2  , STAGE_BYTES = 8 * HTB, NXCD = 8, WGM = 8;

__host__ __device__ __forceinline__ int lds_byte(int r, int c) { const int st = (r >> 4) * 2 + (c >> 5), rr = r & 15, cc = c & 31, ob = rr * 64 + cc * 2; return st * 1024 + (ob ^ (((ob >> 9) & 1) << 5)); }
__host__ __device__ __forceinline__ void stage_rc(int b, int& R, int& C) { const int st = b / 1024, sb = b % 1024, swz = sb ^ (((sb >> 9) & 1) << 5); R = (st >> 1) * 16 + swz / 64; C = (st & 1) * 32 + (swz % 64) / 2; }
__host__ __device__ __forceinline__ int perm32(int rho) { const int n = rho >> 4, i = rho & 15; return 8 * (i >> 2) + 4 * n + (i & 3); }

struct Unit { int pm, pn; };
struct Gemm { const bf16_t* A; const bf16_t* Bt; int M, N, K; };

struct StaticOrder {
    int nM, nN, nwg, G, c;
    __host__ __device__ void init(int M, int N, int G_, int c_) { nM = M / BM; nN = N / BM; nwg = nM * nN; G = G_; c = c_; }
    __host__ __device__ bool next(int i, Unit& u) const {
        const long L = (long)i * G + c; if (L >= nwg) return false;
        int wgid = (int)L; { const int q = nwg / NXCD, r = nwg % NXCD, xcd = wgid % NXCD, off = wgid / NXCD; wgid = (xcd < r ? xcd * (q + 1) : r * (q + 1) + (xcd - r) * q) + off; }
        const int nig = WGM * nN, gid = wgid / nig, fm = gid * WGM, gsz = (nM - fm) < WGM ? (nM - fm) : WGM;
        u.pm = fm + ((wgid % nig) % gsz); u.pn = (wgid % nig) / gsz; return true;
    }
    __device__ __forceinline__ void a_ready(const Unit&) const {}
    __device__ __forceinline__ void done(const Unit&) const {}
};
__device__ __forceinline__ unsigned cvt_pk_bf16(float lo, float hi) { unsigned r; asm volatile("v_cvt_pk_bf16_f32 %0, %1, %2" : "=v"(r) : "v"(lo), "v"(hi)); return r; }
typedef float f32x2 __attribute__((ext_vector_type(2)));
typedef unsigned u32x2 __attribute__((ext_vector_type(2)));
constexpr float RMS_EPS_F = 1e-6f;
constexpr float RSS_SCALE = 16384.0f;
__device__ __forceinline__ float row_rstd(const float* rowss, int row) { return rowss ? __builtin_amdgcn_rsqf((float)((const unsigned*)rowss)[row] * (1.0f / (RSS_SCALE * 1024.0f)) + RMS_EPS_F) : 1.0f; }
__device__ __forceinline__ void st16_wt(void* p, const u32x4 v) { asm volatile("global_store_dwordx4 %0, %1, off sc1\n\ts_nop 1" :: "v"(p), "v"(v) : "memory"); }
constexpr int RSSTAB_OFF = 131072;
__device__ __forceinline__ float rstd_of(unsigned ss) { return __builtin_amdgcn_rsqf((float)ss * (1.0f / (RSS_SCALE * 1024.0f)) + RMS_EPS_F); }
__device__ __forceinline__ float silu_f(float g) { return g * __builtin_amdgcn_rcpf(1.0f + __expf(-g)); }

struct EpiP {
    static constexpr bool PERM = true, AFTER_DRAIN = false, RSS_LDS = true; static constexpr int NVM = 17;
    bf16_t* O; int ldc; const float* rowss;
    __device__ __forceinline__ void operator()(const f32x4 (&acc)[2][2][4][2], const Unit& u, int wr, int wc, int fr, int fq, const PG8_LAS unsigned* rtab) const {
        const int row0 = u.pm * BM + wr * 64 + fr, col0 = u.pn * BM + wc * 32 + 8 * fq;
        unsigned rv[2][4];
#pragma unroll
        for (int ai = 0; ai < 2; ++ai)
#pragma unroll
            for (int m = 0; m < 4; ++m) rv[ai][m] = rtab[wr * 64 + fr + ai * HALF + m * 16];
        asm volatile("" : "+v"(rv[0][0]), "+v"(rv[0][1]), "+v"(rv[0][2]), "+v"(rv[0][3]), "+v"(rv[1][0]), "+v"(rv[1][1]), "+v"(rv[1][2]), "+v"(rv[1][3]));
#pragma unroll
        for (int ai = 0; ai < 2; ++ai)
#pragma unroll
            for (int m = 0; m < 4; ++m) { const int row = row0 + ai * HALF + m * 16; const float rs = rstd_of(rv[ai][m]); bf16_t* rowp = O + (size_t)row * ldc + col0;
#pragma unroll
                for (int bj = 0; bj < 2; ++bj) { const f32x4 v0 = acc[ai][bj][m][0] * rs, v1 = acc[ai][bj][m][1] * rs;
                    u32x4 w; w.x = cvt_pk_bf16(v0[0], v0[1]); w.y = cvt_pk_bf16(v0[2], v0[3]); w.z = cvt_pk_bf16(v1[0], v1[1]); w.w = cvt_pk_bf16(v1[2], v1[3]);
                    st16_wt(rowp + bj * HALF, w); } }
    }
};
struct EpiSwiGLU {
    static constexpr bool PERM = true, AFTER_DRAIN = false, RSS_LDS = true; static constexpr int NVM = 9;
    bf16_t* H; int ldh; const float* rowss;
    __device__ __forceinline__ void operator()(const f32x4 (&acc)[2][2][4][2], const Unit& u, int wr, int wc, int fr, int fq, const PG8_LAS unsigned* rtab) const {
        const int row0 = u.pm * BM + wr * 64 + fr, col0 = u.pn * HALF + wc * 32 + 8 * fq;
        unsigned rv[2][4];
#pragma unroll
        for (int ai = 0; ai < 2; ++ai)
#pragma unroll
            for (int m = 0; m < 4; ++m) rv[ai][m] = rtab[wr * 64 + fr + ai * HALF + m * 16];
        asm volatile("" : "+v"(rv[0][0]), "+v"(rv[0][1]), "+v"(rv[0][2]), "+v"(rv[0][3]), "+v"(rv[1][0]), "+v"(rv[1][1]), "+v"(rv[1][2]), "+v"(rv[1][3]));
#pragma unroll
        for (int ai = 0; ai < 2; ++ai)
#pragma unroll
            for (int m = 0; m < 4; ++m) { const int row = row0 + ai * HALF + m * 16; const float rs = rstd_of(rv[ai][m]);
                float h[8];
#pragma unroll
                for (int n = 0; n < 2; ++n)
#pragma unroll
                    for (int j = 0; j < 4; ++j) { const float g = acc[ai][0][m][n][j] * rs, up = acc[ai][1][m][n][j] * rs; h[4 * n + j] = silu_f(g) * up; }
                u32x4 w; w.x = cvt_pk_bf16(h[0], h[1]); w.y = cvt_pk_bf16(h[2], h[3]); w.z = cvt_pk_bf16(h[4], h[5]); w.w = cvt_pk_bf16(h[6], h[7]);
                st16_wt(H + (size_t)row * ldh + col0, w); }
    }
};
struct EpiRes {
    static constexpr bool PERM = true, AFTER_DRAIN = false, RSS_LDS = false; static constexpr int NVM = 24;
    const bf16_t* Xin; bf16_t* X; float* rowss; int ldc;
    __device__ __forceinline__ void operator()(const f32x4 (&acc)[2][2][4][2], const Unit& u, int wr, int wc, int fr, int fq) const {
        const int row0 = u.pm * BM + wr * 64 + fr, col0 = u.pn * BM + wc * 32 + 8 * fq, ln = 16 * fq + fr;
        u32x4 bs[2][4][2];
#pragma unroll
        for (int ai = 0; ai < 2; ++ai)
#pragma unroll
            for (int m = 0; m < 4; ++m) { const bf16_t* rowi = Xin + (size_t)(row0 + ai * HALF + m * 16) * ldc + col0;
#pragma unroll
                for (int bj = 0; bj < 2; ++bj) bs[ai][m][bj] = *(const u32x4*)(rowi + bj * HALF); }
#pragma unroll
        for (int ai = 0; ai < 2; ++ai)
#pragma unroll
            for (int m = 0; m < 4; ++m) asm volatile("" : "+v"(bs[ai][m][0]), "+v"(bs[ai][m][1]));
        float ssv[2][4];
#pragma unroll
        for (int ai = 0; ai < 2; ++ai)
#pragma unroll
            for (int m = 0; m < 4; ++m) { const int row = row0 + ai * HALF + m * 16; bf16_t* rowp = X + (size_t)row * ldc + col0; float ss = 0.f;
#pragma unroll
                for (int bj = 0; bj < 2; ++bj) { float o[8];
#pragma unroll
                    for (int q = 0; q < 4; ++q) { const unsigned w = bs[ai][m][bj][q]; o[2 * q] = __builtin_bit_cast(float, w << 16) + acc[ai][bj][m][q >> 1][2 * (q & 1)]; o[2 * q + 1] = __builtin_bit_cast(float, w & 0xffff0000u) + acc[ai][bj][m][q >> 1][2 * (q & 1) + 1]; }
#pragma unroll
                    for (int q = 0; q < 8; ++q) ss += o[q] * o[q];
                    u32x4 w; w.x = cvt_pk_bf16(o[0], o[1]); w.y = cvt_pk_bf16(o[2], o[3]); w.z = cvt_pk_bf16(o[4], o[5]); w.w = cvt_pk_bf16(o[6], o[7]);
                    st16_wt(rowp + bj * HALF, w); }
                ssv[ai][m] = ss; }
        float t[2][4];
#pragma unroll
        for (int ai = 0; ai < 2; ++ai)
#pragma unroll
            for (int m = 0; m < 4; ++m) t[ai][m] = __builtin_bit_cast(float, __builtin_amdgcn_ds_bpermute((ln ^ 16) << 2, __builtin_bit_cast(int, ssv[ai][m])));
        asm volatile("" : "+v"(t[0][0]), "+v"(t[0][1]), "+v"(t[0][2]), "+v"(t[0][3]), "+v"(t[1][0]), "+v"(t[1][1]), "+v"(t[1][2]), "+v"(t[1][3]));
#pragma unroll
        for (int ai = 0; ai < 2; ++ai)
#pragma unroll
            for (int m = 0; m < 4; ++m) { ssv[ai][m] += t[ai][m]; t[ai][m] = __builtin_bit_cast(float, __builtin_amdgcn_ds_bpermute((ln ^ 32) << 2, __builtin_bit_cast(int, ssv[ai][m]))); }
        asm volatile("" : "+v"(t[0][0]), "+v"(t[0][1]), "+v"(t[0][2]), "+v"(t[0][3]), "+v"(t[1][0]), "+v"(t[1][1]), "+v"(t[1][2]), "+v"(t[1][3]));
#pragma unroll
        for (int ai = 0; ai < 2; ++ai)
#pragma unroll
            for (int m = 0; m < 4; ++m) if (fq == 0) atomicAdd((unsigned*)rowss + row0 + ai * HALF + m * 16, (unsigned)((ssv[ai][m] + t[ai][m]) * RSS_SCALE + 0.5f));
    }
};

struct EpiResFinal {
    static constexpr bool PERM = true, AFTER_DRAIN = false, RSS_LDS = false; static constexpr int NVM = 0;
    const bf16_t* Xin; float* out; float* rowss; const float* gain; unsigned* cnt; int ldc;
    __device__ __forceinline__ void operator()(const f32x4 (&acc)[2][2][4][2], const Unit& u, int wr, int wc, int fr, int fq) const {
        const int row0 = u.pm * BM + wr * 64 + fr, col0 = u.pn * BM + wc * 32 + 8 * fq, ln = 16 * fq + fr;
        u32x4 bs[2][4][2];
#pragma unroll
        for (int ai = 0; ai < 2; ++ai)
#pragma unroll
            for (int m = 0; m < 4; ++m) { const bf16_t* rowi = Xin + (size_t)(row0 + ai * HALF + m * 16) * ldc + col0;
#pragma unroll
                for (int bj = 0; bj < 2; ++bj) bs[ai][m][bj] = *(const u32x4*)(rowi + bj * HALF); }
#pragma unroll
        for (int ai = 0; ai < 2; ++ai)
#pragma unroll
            for (int m = 0; m < 4; ++m) asm volatile("" : "+v"(bs[ai][m][0]), "+v"(bs[ai][m][1]));
        f32x4 o[2][4][2][2];
#pragma unroll
        for (int ai = 0; ai < 2; ++ai)
#pragma unroll
            for (int m = 0; m < 4; ++m) { const int row = row0 + ai * HALF + m * 16; float ss = 0.f;
#pragma unroll
                for (int bj = 0; bj < 2; ++bj)
#pragma unroll
                    for (int n = 0; n < 2; ++n) { const unsigned w0 = bs[ai][m][bj][2 * n], w1 = bs[ai][m][bj][2 * n + 1];
                        const f32x4 x = (f32x4){__builtin_bit_cast(float, w0 << 16), __builtin_bit_cast(float, w0 & 0xffff0000u), __builtin_bit_cast(float, w1 << 16), __builtin_bit_cast(float, w1 & 0xffff0000u)};
                        const f32x4 v = x + acc[ai][bj][m][n]; o[ai][m][bj][n] = v; ss += v[0] * v[0] + v[1] * v[1] + v[2] * v[2] + v[3] * v[3]; }
                ss += __builtin_bit_cast(float, __builtin_amdgcn_ds_bpermute((ln ^ 16) << 2, __builtin_bit_cast(int, ss))); ss += __builtin_bit_cast(float, __builtin_amdgcn_ds_bpermute((ln ^ 32) << 2, __builtin_bit_cast(int, ss)));
                if (fq == 0) atomicAdd((unsigned*)rowss + row, (unsigned)(ss * RSS_SCALE + 0.5f)); }
        f32x4 gv[2][2];
#pragma unroll
        for (int bj = 0; bj < 2; ++bj)
#pragma unroll
            for (int n = 0; n < 2; ++n) gv[bj][n] = *(const f32x4*)(gain + col0 + bj * HALF + 4 * n);
        asm volatile("s_waitcnt vmcnt(0)" ::: "memory");
        __builtin_amdgcn_s_barrier();
        if (wr == 0 && wc == 0 && ln == 0) { unsigned* c = cnt + 16 * u.pm; (void)__hip_atomic_fetch_add(c, 1u, __ATOMIC_RELAXED, __HIP_MEMORY_SCOPE_AGENT);
            unsigned sp = 0; while (__hip_atomic_load(c, __ATOMIC_RELAXED, __HIP_MEMORY_SCOPE_AGENT) < 4u && ++sp < (1u << 22)) __builtin_amdgcn_s_sleep(1); }
        __builtin_amdgcn_s_barrier();
#pragma unroll
        for (int ai = 0; ai < 2; ++ai)
#pragma unroll
            for (int m = 0; m < 4; ++m) { const int row = row0 + ai * HALF + m * 16;
                const float rs = __builtin_amdgcn_rsqf((float)__hip_atomic_load((unsigned*)rowss + row, __ATOMIC_RELAXED, __HIP_MEMORY_SCOPE_AGENT) * (1.0f / (RSS_SCALE * 1024.0f)) + RMS_EPS_F);
                float* rowp = out + (size_t)row * ldc + col0;
#pragma unroll
                for (int bj = 0; bj < 2; ++bj)
#pragma unroll
                    for (int n = 0; n < 2; ++n) *(f32x4*)(rowp + bj * HALF + 4 * n) = o[ai][m][bj][n] * rs * gv[bj][n]; }
    }
};
template <class Epi, class Sched, bool ALIGN_EPI = false, bool SP2 = false>
__device__ __forceinline__ void gemm_phase(PG8_LAS unsigned char* lds, const Gemm g, const Sched& S, const Epi& E, const int wave_id) {
    int lane_; asm volatile("v_mbcnt_lo_u32_b32 %0, -1, 0\n\tv_mbcnt_hi_u32_b32 %0, -1, %0" : "=v"(lane_)); int tid_ = wave_id * 64 + lane_;
    const int tid = tid_, wid = __builtin_amdgcn_readfirstlane(tid >> 6), lane = tid & 63, wr = wid >> 2, wc = wid & 3, fr = lane & 15, fq = lane >> 4;
    const int K = g.K, nt = K / BK;
    unsigned voffA[2], voffB[2];
#pragma unroll
    for (int i = 0; i < 2; ++i) { int R, C; stage_rc(tid * 16 + i * 8192, R, C); const int Rb = Epi::PERM ? ((R & ~31) + perm32(R & 31)) : R;
        voffA[i] = (unsigned)(R * K + C) * 2u; voffB[i] = (unsigned)(Rb * K + C) * 2u; }
    const size_t kstep = (size_t)(BK * 2);
    const size_t hstep = (size_t)HALF * K * 2;
    const size_t tstep = 2 * hstep;
    const unsigned ldsw = (unsigned)wid * 1024u;
    const int aoff = lds_byte(wr * 64 + fr, fq * 8), boff = lds_byte(wc * 32 + fr, fq * 8);
#define PG8_SA(b, h) (((b) * 2 + (h)) * HTB)
#define PG8_SB(b, h) ((4 + (b) * 2 + (h)) * HTB)
#define PG8_STAGE(bufoff, gbase, voff) do { _Pragma("unroll") for (int _i = 0; _i < 2; ++_i) \
        __builtin_amdgcn_global_load_lds((const unsigned*)((const char*)(gbase) + (voff)[_i]), (PG8_LAS unsigned*)(lds + (bufoff) + ldsw + _i * 8192), 16, 0, 0); } while (0)
#define PG8_LDA(dst, b, h) do { _Pragma("unroll") for (int m = 0; m < 4; ++m) _Pragma("unroll") for (int k = 0; k < 2; ++k) dst[m][k] = *(const PG8_LAS bf16x8*)(lds + PG8_SA(b, h) + aoff + m * 2048 + k * 1024); } while (0)
#define PG8_LDB(dst, b, h) do { _Pragma("unroll") for (int n = 0; n < 2; ++n) _Pragma("unroll") for (int k = 0; k < 2; ++k) dst[n][k] = *(const PG8_LAS bf16x8*)(lds + PG8_SB(b, h) + boff + n * 2048 + k * 1024); } while (0)
#define PG8_MMA(ai, bj, At, Bt) do { __builtin_amdgcn_s_setprio(1); _Pragma("unroll") for (int m = 0; m < 4; ++m) _Pragma("unroll") for (int n = 0; n < 2; ++n) _Pragma("unroll") for (int k = 0; k < 2; ++k) \
        acc[ai][bj][m][n] = __builtin_amdgcn_mfma_f32_16x16x32_bf16(Bt[n][k], At[m][k], acc[ai][bj][m][n], 0, 0, 0); __builtin_amdgcn_s_setprio(0); } while (0)
#define PG8_RSS_PREFETCH(U, par) do { if constexpr (Epi::RSS_LDS) { int l2_; asm volatile("v_mbcnt_lo_u32_b32 %0, -1, 0\n\tv_mbcnt_hi_u32_b32 %0, -1, %0" : "=v"(l2_)); \
        __builtin_amdgcn_global_load_lds((const unsigned*)E.rowss + (size_t)(U).pm * BM + (wid & 3) * 64 + l2_, (PG8_LAS unsigned*)(lds + RSSTAB_OFF + ((par) & 1) * 1024 + (wid & 3) * 256), 4, 0, 0); } } while (0)
#define PG8_WAIT_V(n) asm volatile("s_waitcnt vmcnt(" #n ")" ::: "memory")
#define PG8_WAIT_L(n) asm volatile("s_waitcnt lgkmcnt(" #n ")" ::: "memory")
#define PG8_BAR __builtin_amdgcn_s_barrier()
#define PG8_SCHED __builtin_amdgcn_sched_barrier(0)
    Unit cur, nxt; int ui = 0;
    if (!S.next(0, cur)) return;
    f32x4 acc[2][2][4][2];
#pragma unroll
    for (int a = 0; a < 2; ++a)
#pragma unroll
        for (int b = 0; b < 2; ++b)
#pragma unroll
            for (int m = 0; m < 4; ++m)
#pragma unroll
                for (int n = 0; n < 2; ++n) acc[a][b][m][n] = (f32x4){0.f, 0.f, 0.f, 0.f};
    bf16x8 At[4][2], B0[2][2], B1[2][2];
    const char* cA = (const char*)g.A + (size_t)cur.pm * tstep; const char* cB = (const char*)g.Bt + (size_t)cur.pn * tstep;
    S.a_ready(cur);
    PG8_RSS_PREFETCH(cur, 0);
    if constexpr (SP2) {
        PG8_STAGE(PG8_SB(0, 0), cB, voffB); PG8_STAGE(PG8_SB(0, 1), cB + hstep, voffB); PG8_STAGE(PG8_SA(0, 0), cA, voffA); PG8_STAGE(PG8_SA(0, 1), cA + hstep, voffA);
        if (wr == 1) PG8_BAR;
        PG8_WAIT_V(2); PG8_BAR;
        PG8_STAGE(PG8_SB(1, 0), cB + kstep, voffB); PG8_STAGE(PG8_SA(1, 0), cA + kstep, voffA); PG8_STAGE(PG8_SB(1, 1), cB + hstep + kstep, voffB);
        PG8_WAIT_V(6); PG8_BAR;
    } else {
        PG8_STAGE(PG8_SB(0, 0), cB, voffB); PG8_STAGE(PG8_SA(0, 0), cA, voffA); PG8_STAGE(PG8_SB(0, 1), cB + hstep, voffB); PG8_STAGE(PG8_SA(0, 1), cA + hstep, voffA);
        if (wr == 1) PG8_BAR;
        PG8_WAIT_V(4); PG8_BAR;
        PG8_STAGE(PG8_SB(1, 0), cB + kstep, voffB); PG8_STAGE(PG8_SA(1, 0), cA + kstep, voffA); PG8_STAGE(PG8_SB(1, 1), cB + hstep + kstep, voffB);
        PG8_WAIT_V(6); PG8_BAR;
    }
    for (;;) {
        const bool has_next = S.next(ui + 1, nxt);
        const char* nA = has_next ? (const char*)g.A + (size_t)nxt.pm * tstep : cA; const char* nB = has_next ? (const char*)g.Bt + (size_t)nxt.pn * tstep : cB;
        for (int t = 0; t < nt; t += 2) {
            const bool last = (t == nt - 2);
            const char* a1 = cA + (size_t)(t + 1) * kstep;
            const char* a2 = last ? nA : cA + (size_t)(t + 2) * kstep; const char* b2 = last ? nB : cB + (size_t)(t + 2) * kstep;
            const char* a3 = a2 + kstep; const char* b3 = b2 + kstep;
            if (last && has_next) S.a_ready(nxt);
            if constexpr (SP2) {
            PG8_LDB(B0, 0, 0); PG8_LDB(B1, 0, 1); PG8_SCHED; PG8_LDA(At, 0, 0); PG8_STAGE(PG8_SA(1, 1), a1 + hstep, voffA);
            PG8_WAIT_V(8); PG8_WAIT_L(0); PG8_BAR; PG8_MMA(0, 0, At, B0); PG8_MMA(0, 1, At, B1); PG8_BAR; PG8_SCHED;
            PG8_LDA(At, 0, 1); PG8_STAGE(PG8_SB(0, 0), b2, voffB); PG8_STAGE(PG8_SB(0, 1), b2 + hstep, voffB); PG8_STAGE(PG8_SA(0, 0), a2, voffA);
            PG8_WAIT_V(8); PG8_WAIT_L(0); PG8_BAR; PG8_MMA(1, 0, At, B0); PG8_MMA(1, 1, At, B1); PG8_BAR; PG8_SCHED;
            PG8_LDB(B0, 1, 0); PG8_LDB(B1, 1, 1); PG8_SCHED; PG8_LDA(At, 1, 0); PG8_STAGE(PG8_SA(0, 1), a2 + hstep, voffA);
            PG8_WAIT_V(8); PG8_WAIT_L(0); PG8_BAR; PG8_MMA(0, 0, At, B0); PG8_MMA(0, 1, At, B1); PG8_BAR; PG8_SCHED;
            PG8_LDA(At, 1, 1); PG8_STAGE(PG8_SB(1, 0), b3, voffB); PG8_STAGE(PG8_SB(1, 1), b3 + hstep, voffB); PG8_STAGE(PG8_SA(1, 0), a3, voffA);
            PG8_WAIT_V(8); PG8_WAIT_L(0); PG8_BAR; PG8_MMA(1, 0, At, B0); PG8_MMA(1, 1, At, B1); PG8_BAR; PG8_SCHED;
            } else {
            PG8_LDB(B0, 0, 0); PG8_SCHED; PG8_LDA(At, 0, 0); PG8_STAGE(PG8_SA(1, 1), a1 + hstep, voffA);
            PG8_WAIT_L(8); PG8_BAR; PG8_WAIT_L(0); PG8_MMA(0, 0, At, B0); PG8_BAR; PG8_SCHED;
            PG8_LDB(B1, 0, 1); PG8_STAGE(PG8_SB(0, 0), b2, voffB);
            PG8_BAR; PG8_WAIT_L(0); PG8_MMA(0, 1, At, B1); PG8_BAR;
            PG8_LDA(At, 0, 1); PG8_STAGE(PG8_SA(0, 0), a2, voffA);
            PG8_BAR; PG8_WAIT_L(0); PG8_MMA(1, 0, At, B0); PG8_BAR; PG8_SCHED;
            PG8_STAGE(PG8_SB(0, 1), b2 + hstep, voffB);
            PG8_WAIT_V(6); PG8_BAR; PG8_MMA(1, 1, At, B1); PG8_BAR;
            PG8_LDB(B0, 1, 0); PG8_SCHED; PG8_LDA(At, 1, 0); PG8_STAGE(PG8_SA(0, 1), a2 + hstep, voffA);
            PG8_WAIT_L(8); PG8_BAR; PG8_WAIT_L(0); PG8_MMA(0, 0, At, B0); PG8_BAR; PG8_SCHED;
            PG8_LDB(B1, 1, 1); PG8_STAGE(PG8_SB(1, 0), b3, voffB);
            PG8_BAR; PG8_WAIT_L(0); PG8_MMA(0, 1, At, B1); PG8_BAR;
            PG8_LDA(At, 1, 1); PG8_STAGE(PG8_SA(1, 0), a3, voffA);
            PG8_BAR; PG8_WAIT_L(0); PG8_MMA(1, 0, At, B0); PG8_BAR; PG8_SCHED;
            PG8_STAGE(PG8_SB(1, 1), b3 + hstep, voffB);
            PG8_WAIT_V(6); PG8_BAR; PG8_MMA(1, 1, At, B1); PG8_BAR;
            }
        }
        if constexpr (ALIGN_EPI) { if (wr == 0) PG8_BAR; }
        if constexpr (Epi::RSS_LDS) { E(acc, cur, wr, wc, fr, fq, (const PG8_LAS unsigned*)(lds + RSSTAB_OFF + (ui & 1) * 1024)); S.done(cur); }
        else if constexpr (!Epi::AFTER_DRAIN) { E(acc, cur, wr, wc, fr, fq); S.done(cur); }
        if (!has_next) break;
#pragma unroll
        for (int a = 0; a < 2; ++a)
#pragma unroll
            for (int b = 0; b < 2; ++b)
#pragma unroll
                for (int m = 0; m < 4; ++m)
#pragma unroll
                    for (int n = 0; n < 2; ++n) acc[a][b][m][n] = (f32x4){0.f, 0.f, 0.f, 0.f};
        cur = nxt; cA = nA; cB = nB; ++ui;
        PG8_RSS_PREFETCH(cur, ui);
        if constexpr (ALIGN_EPI) { if (wr == 1) PG8_BAR; }
    }
    PG8_WAIT_V(0);
    if constexpr (!ALIGN_EPI) { if (wr == 0) PG8_BAR; }
    PG8_BAR;
    if constexpr (Epi::AFTER_DRAIN) { E.fused(acc, cur, wr, wc, fr, fq, lds, wid, lane); S.done(cur); }
#undef PG8_SA
#undef PG8_SB
#undef PG8_STAGE
#undef PG8_LDA
#undef PG8_LDB
#undef PG8_MMA
#undef PG8_WAIT_V
#undef PG8_RSS_PREFETCH
#undef PG8_WAIT_L
#undef PG8_BAR
#undef PG8_SCHED
}
}

constexpr int NWAVES = 8;
#ifndef MK_N_LAUNCHES
#define MK_N_LAUNCHES 1
#endif
constexpr int NPH = 12;
constexpr int N_LAUNCHES = MK_N_LAUNCHES;

constexpr int BATCH = 16, SEQ = 2048, DM = 1024, DEPTH = 2, M = BATCH * SEQ;
constexpr int PC = 3976, PCP = 4096, DFF = 2816, NGU = 2 * DFF;
constexpr int C_MQ = 0, C_MK = 256, C_MV = 512, C_MO = 768, C_MGI = 1024, C_MGF = 1028;
constexpr int C_RQ = 1032, C_RK = 1416, C_RV = 1800, C_RG = 2184;
constexpr int C_WR = 2568, C_WK = 2952, C_WV = 3336, C_WWL = 3720, C_WAL = 3784, C_WGL = 3848;
constexpr int WCOLS = 1408;
constexpr int Y_M = 0, Y_R = 256, Y_W = 640;

constexpr size_t MiB = 1u << 20;
constexpr size_t WS_CTL = 0, CTL_ZERO_BYTES = 2 * MiB;
constexpr size_t WS_RSS = 1 * MiB;
constexpr size_t WS_WIN = 2 * MiB, WS_WOUT = 18 * MiB, WS_WGU = 22 * MiB, WS_WDN = 44 * MiB;
constexpr size_t WS_LORA = 55 * MiB; constexpr int LORA_L = 384 * 256;
constexpr size_t WS_A1 = 56 * MiB;
constexpr size_t WS_XB = 120 * MiB;
constexpr size_t WS_XB2 = 440 * MiB;
constexpr size_t WS_A3 = 56 * MiB;
constexpr size_t WS_P = 184 * MiB;
constexpr size_t WS_END = 504 * MiB;
constexpr int CW_BAR = 4096;
constexpr int CW_PANEL = 16384;

constexpr int RING_OFF = 0, RING_BYTES = 131072;
constexpr int LDS_BYTES = 147456;
constexpr int LDSCTL_OFF = LDS_BYTES - 512, MISC_OFF = LDSCTL_OFF + 320;

#define GAS __attribute__((address_space(1)))
#define LAS __attribute__((address_space(3)))
typedef unsigned short bf16;
typedef unsigned v4u __attribute__((ext_vector_type(4)));
typedef float f32x4 __attribute__((ext_vector_type(4)));
typedef short bf16x8 __attribute__((ext_vector_type(8)));
typedef GAS unsigned gu32;
typedef GAS unsigned long long gu64;
#define RLX_AGENT __ATOMIC_RELAXED, __HIP_MEMORY_SCOPE_AGENT
#define LDS_WAIT() asm volatile("s_waitcnt lgkmcnt(0)" ::: "memory")
#define VM_WAIT() asm volatile("s_waitcnt vmcnt(0)" ::: "memory")
__device__ __forceinline__ unsigned long long rt() { return __builtin_amdgcn_s_memrealtime(); }
typedef __bf16 bf16v2_t __attribute__((ext_vector_type(2))); typedef float f32v2_t __attribute__((ext_vector_type(2)));
__device__ __forceinline__ unsigned pk2(float lo, float hi) { const f32v2_t f = {lo, hi}; const bf16v2_t v = __builtin_convertvector(f, bf16v2_t); return __builtin_bit_cast(unsigned, v); }
__device__ __forceinline__ unsigned f2bf(float f) { return pk2(f, f); }
#define XB_TMO      128
#define XB_XCNT(j)  (256  + 64 * (j))
#define XB_XSUB(j)  (1280 + 64 * (j))
#define XB_XGEN(j)  (2304 + 64 * (j))
#define XB_TOP      3328
#define XB_TOPGEN   3392
#define XCD_BAR_WORDS 3456
#define XB_SPIN_CAP (1u << 18)

__device__ __forceinline__ unsigned xb_ld(unsigned* p)              { return __hip_atomic_load(p, __ATOMIC_RELAXED, __HIP_MEMORY_SCOPE_AGENT); }
__device__ __forceinline__ unsigned xb_add(unsigned* p, unsigned v) { return __hip_atomic_fetch_add(p, v, __ATOMIC_RELAXED, __HIP_MEMORY_SCOPE_AGENT); }
__device__ __forceinline__ unsigned xb_xcc_id() { return (unsigned)__builtin_amdgcn_s_getreg((3 << 11) | 20) & 0xFu; }
#define XB_SPIN(cond, bar) do { unsigned _sp = 0; while (cond) { __builtin_amdgcn_s_sleep(1); \
    if ((++_sp & 255u) == 0u) { if (xb_ld(&(bar)[XB_TMO])) break; if (_sp > XB_SPIN_CAP) { atomicAdd(&(bar)[XB_TMO], 1u); break; } } } } while (0)

struct XcdBarrier {
    unsigned* bar; unsigned x;
    volatile LAS unsigned* st;
};

__device__ __forceinline__ XcdBarrier xcd_barrier_post(unsigned* bar, volatile LAS unsigned* st) {
    XcdBarrier b; b.bar = bar; b.x = xb_xcc_id(); b.st = st;
    if (threadIdx.x == 0) (void)xb_add(&bar[XB_XCNT(b.x)], 1u);
    return b;
}
__device__ __forceinline__ void xcd_barrier_complete(unsigned* bar, unsigned x, unsigned& nloc, unsigned& nx) {
    const unsigned G = gridDim.x * gridDim.y * gridDim.z;
    unsigned sum, cnt, mine, sp = 0u;
    for (;;) {
        sum = 0u; cnt = 0u; mine = 0u;
#pragma unroll
        for (unsigned j = 0; j < 16; ++j) { const unsigned c = xb_ld(&bar[XB_XCNT(j)]); sum += c; cnt += (c > 0u) ? 1u : 0u; mine = (j == x) ? c : mine; }
        if (sum == G) break;
        __builtin_amdgcn_s_sleep(1);
        if ((++sp & 255u) == 0u) { if (xb_ld(&bar[XB_TMO])) break; if (sp > XB_SPIN_CAP) { atomicAdd(&bar[XB_TMO], 1u); break; } }
    }
    nloc = mine > 0u ? mine : 1u; nx = cnt > 0u ? cnt : 1u;
}

__device__ __forceinline__ void xcd_barrier(const XcdBarrier& b, const bool leader  ) {
    asm volatile("s_waitcnt vmcnt(0)" ::: "memory");
    __syncthreads();
    if (leader) {
        GAS unsigned* barg = (GAS unsigned*)b.bar; unsigned bx_ = b.x; asm volatile("" : "+s"(barg), "+s"(bx_)); unsigned* bar = (unsigned*)barg;
        __builtin_amdgcn_s_waitcnt(0);
        unsigned nloc = b.st[0], nx = b.st[1];
        if (nloc == 0u) { xcd_barrier_complete(bar, bx_, nloc, nx); b.st[0] = nloc; b.st[1] = nx; }
        const unsigned old = xb_add(&bar[XB_XSUB(bx_)], 1u);
        const unsigned gen = old / nloc;
        if (old + 1u == (gen + 1u) * nloc) {
            __builtin_amdgcn_fence(__ATOMIC_RELEASE, "agent");
            asm volatile("s_waitcnt vmcnt(0)" ::: "memory");
            const unsigned og = xb_add(&bar[XB_TOP], 1u);
            const unsigned tg = og / nx;
            if (og + 1u == (tg + 1u) * nx) xb_add(&bar[XB_TOPGEN], 1u);
            else XB_SPIN(xb_ld(&bar[XB_TOPGEN]) == tg, bar);
            __builtin_amdgcn_fence(__ATOMIC_ACQUIRE, "agent");
            xb_add(&bar[XB_XGEN(bx_)], 1u);
            asm volatile("s_waitcnt vmcnt(0)" ::: "memory");
        } else {
            XB_SPIN(xb_ld(&bar[XB_XGEN(bx_)]) == gen, bar);
            __builtin_amdgcn_fence(__ATOMIC_ACQUIRE, "agent");
            asm volatile("s_waitcnt vmcnt(0)" ::: "memory");
        }
    }
    __syncthreads();
}

struct Frame {
    LAS unsigned char* lds;
    volatile LAS unsigned* MISC;
    gu32* ctl;
    int wave;
    int vcu, G;
    float* out; unsigned char* ws;
};
__device__ __forceinline__ int flane() { int x; asm volatile("v_mbcnt_lo_u32_b32 %0, -1, 0\n\tv_mbcnt_hi_u32_b32 %0, -1, %0" : "=v"(x)); return x; }
#define FTID(F) ((F).wave * 64 + flane())
typedef unsigned u32x2_t __attribute__((ext_vector_type(2)));
struct Args { const float* in[24]; float* out; unsigned char* ws; int ph_lo, ph_hi, li, pad; };
template <int CTRL> __device__ __forceinline__ float dpp_mov(float x) { return __builtin_bit_cast(float, __builtin_amdgcn_update_dpp(0, __builtin_bit_cast(int, x), CTRL, 0xf, 0xf, true)); }
__device__ __forceinline__ float wave_sum(float x) {
    x += dpp_mov<0x140>(x); x += dpp_mov<0x141>(x); x += dpp_mov<0xB1>(x); x += dpp_mov<0x4E>(x);
    const int xi = __builtin_bit_cast(int, x);
    const float r0 = __builtin_bit_cast(float, __builtin_amdgcn_readlane(xi, 0)), r1 = __builtin_bit_cast(float, __builtin_amdgcn_readlane(xi, 16)),
                r2 = __builtin_bit_cast(float, __builtin_amdgcn_readlane(xi, 32)), r3 = __builtin_bit_cast(float, __builtin_amdgcn_readlane(xi, 48));
    return (r0 + r1) + (r2 + r3);
}
__device__ __forceinline__ float bperm(float x, int idx) { return __builtin_bit_cast(float, __builtin_amdgcn_ds_bpermute(idx << 2, __builtin_bit_cast(int, x))); }
__device__ __forceinline__ float red8(float x) { x += dpp_mov<0x141>(x); x += dpp_mov<0xB1>(x); x += dpp_mov<0x4E>(x); return x; }
__device__ __forceinline__ float bflo(unsigned w) { return __builtin_bit_cast(float, w << 16); }
__device__ __forceinline__ float bfhi(unsigned w) { return __builtin_bit_cast(float, w & 0xffff0000u); }
__device__ __forceinline__ void ld8g(const bf16* p, float (&v)[8]) { const v4u w = *(const v4u*)p;
    v[0] = bflo(w.x); v[1] = bfhi(w.x); v[2] = bflo(w.y); v[3] = bfhi(w.y); v[4] = bflo(w.z); v[5] = bfhi(w.z); v[6] = bflo(w.w); v[7] = bfhi(w.w); }
__device__ __forceinline__ void ld8l(const LAS bf16* p, float (&v)[8]) { const v4u w = *(const LAS v4u*)p;
    v[0] = bflo(w.x); v[1] = bfhi(w.x); v[2] = bflo(w.y); v[3] = bfhi(w.y); v[4] = bflo(w.z); v[5] = bfhi(w.z); v[6] = bflo(w.w); v[7] = bfhi(w.w); }
__device__ __forceinline__ void ld8f(const float* p, float (&v)[8]) { const f32x4 a = *(const f32x4*)p, b = *(const f32x4*)(p + 4);
    v[0] = a.x; v[1] = a.y; v[2] = a.z; v[3] = a.w; v[4] = b.x; v[5] = b.y; v[6] = b.z; v[7] = b.w; }
__device__ __forceinline__ void ld8lf(const LAS float* p, float (&v)[8]) { const f32x4 a = *(const LAS f32x4*)p, b = *(const LAS f32x4*)(p + 4);
    v[0] = a.x; v[1] = a.y; v[2] = a.z; v[3] = a.w; v[4] = b.x; v[5] = b.y; v[6] = b.z; v[7] = b.w; }
__device__ __forceinline__ void st8lf(LAS float* p, const float (&v)[8]) { *(LAS f32x4*)p = (f32x4){v[0], v[1], v[2], v[3]}; *(LAS f32x4*)(p + 4) = (f32x4){v[4], v[5], v[6], v[7]}; }
__device__ __forceinline__ v4u pack8(const float (&v)[8]) { v4u w; w.x = pk2(v[0], v[1]); w.y = pk2(v[2], v[3]); w.z = pk2(v[4], v[5]); w.w = pk2(v[6], v[7]); return w; }
__device__ __forceinline__ float sigmoid_f(float x) { return __builtin_amdgcn_rcpf(1.0f + __expf(-x)); }
__device__ __forceinline__ float silu2_f(float x) { return x * sigmoid_f(x); }
__device__ __forceinline__ float softplus_f(float z) { return fmaxf(z, 0.f) + __logf(1.0f + __expf(-fabsf(z))); }
__device__ __forceinline__ float tanh_f(float x) { return 1.0f - 2.0f * __builtin_amdgcn_rcpf(1.0f + __expf(2.0f * x)); }

typedef short s16x4p_t __attribute__((ext_vector_type(4))); typedef unsigned u32x2p_t __attribute__((ext_vector_type(2)));
__device__ __forceinline__ void p0_transpose_item(const float* W, int K, int N, bf16* WT, int mode, LAS float* scr, int kb, int nb, int lane, const float* gain = nullptr) {
    LAS bf16* T = (LAS bf16*)scr;
    const int k0 = 64 * kb, n0 = 64 * nb, r = lane >> 4, c = lane & 15;
    const bool inb = (n0 + 4 * c) < N;
    f32x4 v[16];
#pragma unroll
    for (int j = 0; j < 16; ++j) v[j] = inb ? *(const f32x4*)(W + (size_t)(k0 + 4 * j + r) * N + n0 + 4 * c) : (f32x4){0.f, 0.f, 0.f, 0.f};
    if (gain) {
#pragma unroll
        for (int j = 0; j < 16; ++j) v[j] = v[j] * gain[k0 + 4 * j + r]; }
#pragma unroll
    for (int j = 0; j < 16; ++j) { u32x2p_t w; w.x = pk2(v[j].x, v[j].y); w.y = pk2(v[j].z, v[j].w); *(LAS u32x2p_t*)(T + (4 * j + r) * 72 + 4 * c) = w; }
    LDS_WAIT(); asm volatile("" ::: "memory");
    const int i = lane & 15, fq = lane >> 4;
#pragma unroll
    for (int nbk = 0; nbk < 4; ++nbk)
#pragma unroll
        for (int it = 0; it < 2; ++it) { const int kg = fq + 4 * it; const LAS bf16* a = T + (8 * kg + (i >> 2)) * 72 + 16 * nbk + 4 * (i & 3);
            const u32x2p_t lo = __builtin_bit_cast(u32x2p_t, __builtin_amdgcn_ds_read_tr16_b64_v4i16((LAS s16x4p_t*)a)), hi = __builtin_bit_cast(u32x2p_t, __builtin_amdgcn_ds_read_tr16_b64_v4i16((LAS s16x4p_t*)(a + 4 * 72)));
            const int ng = n0 + 16 * nbk + i; const int drow = (mode == 0) ? ng : ((ng >> 7) * 256 + (ng & 127) + (mode == 2 ? 128 : 0));
            *(GAS v4u*)(WT + (size_t)drow * K + k0 + 8 * kg) = (v4u){lo.x, lo.y, hi.x, hi.y}; }
    LDS_WAIT(); asm volatile("" ::: "memory");
}
constexpr int I_IN = 16 * 64, I_OUT = 16 * 16, I_G = 16 * 44, I_D = 44 * 16, I_L = I_IN + I_OUT + 2 * I_G + I_D;
__device__ __forceinline__ void weight_item(Frame& F, const Args& A, LAS float* scr, int it, int lane_) {
    const int l = it / I_L; int r = it % I_L;
    if (r < I_IN) { p0_transpose_item(A.in[1] + (size_t)l * DM * PC, DM, PC, (bf16*)(F.ws + WS_WIN) + (size_t)l * PCP * DM, 0, scr, r / 64, r % 64, lane_, A.in[2] + l * DM); return; } r -= I_IN;
    if (r < I_OUT) { p0_transpose_item(A.in[20] + (size_t)l * DM * DM, DM, DM, (bf16*)(F.ws + WS_WOUT) + (size_t)l * DM * DM, 0, scr, r / 16, r % 16, lane_); return; } r -= I_OUT;
    if (r < I_G) { p0_transpose_item(A.in[21] + (size_t)l * DM * DFF, DM, DFF, (bf16*)(F.ws + WS_WGU) + (size_t)l * NGU * DM, 1, scr, r / 44, r % 44, lane_, A.in[3] + l * DM); return; } r -= I_G;
    if (r < I_G) { p0_transpose_item(A.in[22] + (size_t)l * DM * DFF, DM, DFF, (bf16*)(F.ws + WS_WGU) + (size_t)l * NGU * DM, 2, scr, r / 44, r % 44, lane_, A.in[3] + l * DM); return; } r -= I_G;
    p0_transpose_item(A.in[23] + (size_t)l * DFF * DM, DFF, DM, (bf16*)(F.ws + WS_WDN) + (size_t)l * DM * DFF, 0, scr, r / 16, r % 16, lane_);
}
__device__ __forceinline__ void lora_item(Frame& F, const Args& A, LAS float* scr, int l, int r, int lane_) {
    bf16* lw = (bf16*)(F.ws + WS_LORA) + (size_t)l * LORA_L;
    if (r < 6) p0_transpose_item(A.in[11] + (size_t)l * 64 * 384, 64, 384, lw, 0, scr, 0, r, lane_);
    else if (r < 12) p0_transpose_item(A.in[13] + (size_t)l * 64 * 384, 64, 384, lw + 384 * 64, 0, scr, 0, r - 6, lane_);
    else p0_transpose_item(A.in[14] + (size_t)l * 128 * 384, 128, 384, lw + 2 * 384 * 64, 0, scr, (r - 12) / 6, (r - 12) % 6, lane_);
}
__device__ __forceinline__ void deferred_weights(Frame& F, const Args& A, int worker) {
    const int lane_ = flane(); LAS float* scr = (LAS float*)(F.lds + RING_OFF + F.wave * 16384);
    const int gw = worker * NWAVES + F.wave, NGW = 160 * NWAVES;
    for (int it = I_IN + gw; it < DEPTH * I_L; it += NGW) weight_item(F, A, scr, it, lane_);
    for (int r = gw; r < 24; r += NGW) lora_item(F, A, scr, 1, r, lane_);
}
__device__ __forceinline__ void p0_prologue(Frame& F, const Args& A) {
    const int lane_ = flane();
    LAS float* scr = (LAS float*)(F.lds + RING_OFF + F.wave * 16384);
    const int gw = F.vcu * NWAVES + F.wave, NGW = F.G * NWAVES;
    const float* x = A.in[0]; bf16* xb = (bf16*)(F.ws + WS_XB); float* rss = (float*)(F.ws + WS_RSS);
    for (int ph = 0; ph < 2; ++ph) {
        if ((ph ^ (F.wave & 1)) != 0) {
            for (int it = gw; it < I_IN; it += NGW) weight_item(F, A, scr, it, lane_);
            for (int r = gw; r < 24; r += NGW) lora_item(F, A, scr, 0, r, lane_);
            if (F.G != 256) { for (int it = I_IN + gw; it < DEPTH * I_L; it += NGW) weight_item(F, A, scr, it, lane_); for (int r = gw; r < 24; r += NGW) lora_item(F, A, scr, 1, r, lane_); }
        } else {
            for (int m = gw; m < M; m += 2 * NGW) {
                const int m2 = m + NGW < M ? m + NGW : m;
                const GAS f32x4* xr0 = (const GAS f32x4*)(x + (size_t)m * DM) + lane_; const GAS f32x4* xr1 = (const GAS f32x4*)(x + (size_t)m2 * DM) + lane_;
                f32x4 v0[4], v1[4]; float s0 = 0.f, s1 = 0.f;
#pragma unroll
                for (int j = 0; j < 4; ++j) { v0[j] = xr0[64 * j]; v1[j] = xr1[64 * j]; }
#pragma unroll
                for (int j = 0; j < 4; ++j) { s0 += (v0[j].x * v0[j].x + v0[j].y * v0[j].y) + (v0[j].z * v0[j].z + v0[j].w * v0[j].w); s1 += (v1[j].x * v1[j].x + v1[j].y * v1[j].y) + (v1[j].z * v1[j].z + v1[j].w * v1[j].w); }
                s0 = wave_sum(s0); s1 = wave_sum(s1);
                GAS unsigned long long* o0 = (GAS unsigned long long*)(xb + (size_t)m * DM) + lane_; GAS unsigned long long* o1 = (GAS unsigned long long*)(xb + (size_t)m2 * DM) + lane_;
#pragma unroll
                for (int j = 0; j < 4; ++j) o0[64 * j] = (unsigned long long)pk2(v0[j].x, v0[j].y) | ((unsigned long long)pk2(v0[j].z, v0[j].w) << 32);
                if (lane_ == 0) ((unsigned*)rss)[m] = (unsigned)(s0 * pg8::RSS_SCALE + 0.5f);
                if (m2 != m) {
#pragma unroll
                    for (int j = 0; j < 4; ++j) o1[64 * j] = (unsigned long long)pk2(v1[j].x, v1[j].y) | ((unsigned long long)pk2(v1[j].z, v1[j].w) << 32);
                    if (lane_ == 0) ((unsigned*)rss)[m2] = (unsigned)(s1 * pg8::RSS_SCALE + 0.5f); }
            }
        }
    }
}
__device__ __forceinline__ void final_norm(Frame& F, const Args& A) {
    int lane_ = flane(); asm volatile("" : "+v"(lane_));
    const int gw = F.vcu * NWAVES + F.wave, NGW = F.G * NWAVES; const float* gf = A.in[4]; const bf16* xb = (const bf16*)(F.ws + WS_XB); const float* rss = (const float*)(F.ws + WS_RSS) + (size_t)4 * M;
    f32x4 gv[4];
#pragma unroll
    for (int j = 0; j < 4; ++j) gv[j] = ((const f32x4*)gf)[lane_ + 64 * j];
    for (int m = gw; m < M; m += 2 * NGW) {
        const int m2 = m + NGW < M ? m + NGW : m;
        const GAS unsigned long long* xr0 = (const GAS unsigned long long*)(xb + (size_t)m * DM) + lane_; const GAS unsigned long long* xr1 = (const GAS unsigned long long*)(xb + (size_t)m2 * DM) + lane_;
        unsigned long long w0[4], w1[4];
#pragma unroll
        for (int j = 0; j < 4; ++j) { w0[j] = xr0[64 * j]; w1[j] = xr1[64 * j]; }
        const float rs0 = pg8::row_rstd(rss, m), rs1 = pg8::row_rstd(rss, m2);
        GAS f32x4* o0 = (GAS f32x4*)(F.out + (size_t)m * DM) + lane_; GAS f32x4* o1 = (GAS f32x4*)(F.out + (size_t)m2 * DM) + lane_;
#pragma unroll
        for (int j = 0; j < 4; ++j) { const unsigned lo = (unsigned)w0[j], hi = (unsigned)(w0[j] >> 32); o0[64 * j] = (f32x4){bflo(lo), bfhi(lo), bflo(hi), bfhi(hi)} * rs0 * gv[j]; }
        if (m2 != m) {
#pragma unroll
            for (int j = 0; j < 4; ++j) { const unsigned lo = (unsigned)w1[j], hi = (unsigned)(w1[j] >> 32); o1[64 * j] = (f32x4){bflo(lo), bfhi(lo), bflo(hi), bfhi(hi)} * rs1 * gv[j]; } }
    }
}

__device__ __forceinline__ int launder(int x) { asm volatile("" : "+v"(x)); return x; }
constexpr int XW_LD = 72, XG_LD = 136;
constexpr int TS = 72, US = 40;
constexpr int RO_WD = 0, RO_G = 16384, RO_AP = 32768, RO_X = 49152, RO_WT = 86016, RO_MU = 88064, RO_PAR = 89856, RO_TOP = 91648;
static_assert(RO_X + 35840 <= RO_WT && RO_TOP <= LDSCTL_OFF, "RWKV prep LDS map");
struct Sh8 { v4u cur, prv; };
__device__ __forceinline__ void sh8_issue(Sh8& s, const bf16* prow, int pofs, int col) { s.cur = *(const v4u*)(prow + col); s.prv = *(const v4u*)(prow - pofs + col); }
__device__ __forceinline__ void sh8_pin(Sh8& s) { asm volatile("" : "+v"(s.cur), "+v"(s.prv)); }
__device__ __forceinline__ void unpack8(const v4u w, float (&v)[8]) { v[0] = bflo(w.x); v[1] = bfhi(w.x); v[2] = bflo(w.y); v[3] = bfhi(w.y); v[4] = bflo(w.z); v[5] = bfhi(w.z); v[6] = bflo(w.w); v[7] = bfhi(w.w); }
__device__ __forceinline__ void sh8_get(const Sh8& s, bool has_prev, const LAS float* mu8, float (&o)[8]) {
    float cur[8], prv[8], m8[8]; unpack8(s.cur, cur); unpack8(s.prv, prv); ld8lf(mu8, m8);
#pragma unroll
    for (int j = 0; j < 8; ++j) o[j] = cur[j] + m8[j] * ((has_prev ? prv[j] : 0.f) - cur[j]);
}
typedef short s16x4_t __attribute__((ext_vector_type(4)));
__device__ __forceinline__ bf16x8 tr_frag(const LAS bf16* blk, int ld, int lane) {
    const int i = lane & 15; const LAS bf16* a = blk + (i >> 2) * ld + 4 * (i & 3);
    const s16x4_t lo = __builtin_amdgcn_ds_read_tr16_b64_v4i16((LAS s16x4_t*)a), hi = __builtin_amdgcn_ds_read_tr16_b64_v4i16((LAS s16x4_t*)(a + 4 * ld));
    return (bf16x8){lo[0], lo[1], lo[2], lo[3], hi[0], hi[1], hi[2], hi[3]};
}
__device__ __forceinline__ u32x2_t tr4(const LAS bf16* blk, int ld, int lane) { const int i = lane & 15; const s16x4_t r = __builtin_amdgcn_ds_read_tr16_b64_v4i16((LAS s16x4_t*)(blk + (i >> 2) * ld + 4 * (i & 3))); return __builtin_bit_cast(u32x2_t, r); }
__device__ __forceinline__ bf16x8 frag2(u32x2_t lo, u32x2_t hi) { const v4u w = (v4u){lo.x, lo.y, hi.x, hi.y}; return __builtin_bit_cast(bf16x8, w); }
__device__ __forceinline__ u32x2_t cvt4(f32x4 a) { u32x2_t w; w.x = pk2(a[0], a[1]); w.y = pk2(a[2], a[3]); return w; }
#define MFMA16(a, b, c) __builtin_amdgcn_mfma_f32_16x16x32_bf16((a), (b), (c), 0, 0, 0)
#define LDFRAG(p) (*(const LAS bf16x8*)(p))
constexpr int TILE_B = 4 * 8192 + 8192 + 1024 + 256, TO_G = 32768, TO_GT = 40960, TO_BS = 41984;
static_assert((size_t)96 * 32 * TILE_B <= (size_t)M * DM * 4, "RWKV operand tiles fit in d_out");
__device__ __forceinline__ void rwkv_prep_block(Frame& F, const Args& A, int l, int u, int cb) {
    const int b = u / 6, h = u % 6;
    LAS unsigned char* L = F.lds;
    LAS float* Wd = (LAS float*)(L + RO_WD); LAS float* G = (LAS float*)(L + RO_G); LAS float* AP = (LAS float*)(L + RO_AP);
    LAS bf16* XW = (LAS bf16*)(L + RO_X); LAS bf16* XA = XW + 64 * XW_LD; LAS bf16* XG = XA + 64 * XW_LD;
    LAS float* WT = (LAS float*)(L + RO_WT); LAS float* MU = (LAS float*)(L + RO_MU); LAS float* PAR = (LAS float*)(L + RO_PAR);
    GAS unsigned char* wsu = (GAS unsigned char*)F.ws; asm volatile("" : "+s"(wsu)); const bf16* P = (const bf16*)(wsu + WS_P);
    GAS unsigned char* tiles = (GAS unsigned char*)F.out; asm volatile("" : "+s"(tiles));
    int tid_ = FTID(F); asm volatile("" : "+v"(tid_)); const int tid = tid_, tok_ = tid >> 3, cs_ = tid & 7;
    const int lane = tid & 63, fr = lane & 15, fq = lane >> 4, wave = F.wave;
    const int nt = wave & 3, mh = wave >> 2;
    const bf16* lw_ = (const bf16*)(wsu + WS_LORA) + (size_t)l * LORA_L;
    __syncthreads();
    if (tid < 448) { const float* mu = A.in[9] + (size_t)l * WCOLS; const int q = tid >> 6, ch = tid & 63;
        const int src = q < 3 ? (384 * q + 64 * h + ch) : (q < 5 ? (1152 + 64 * (q - 3) + ch) : (1280 + 64 * (q - 5) + ch)); MU[tid] = mu[src];
        const float* ps = q == 0 ? A.in[10] : q == 1 ? A.in[12] : q == 2 ? A.in[15] : q == 3 ? A.in[16] : q == 4 ? A.in[17] : q == 5 ? A.in[18] : A.in[19]; PAR[tid] = ps[l * 384 + 64 * h + ch]; }
    bf16x8 bw[2], ba[2], bg[4];
    { const int frl = launder(fr), fql = launder(fq);
        const bf16* pbw = lw_ + (size_t)(64 * h + 16 * nt + frl) * 64 + 8 * fql; const bf16* pba = pbw + 384 * 64; const bf16* pbg = lw_ + 2 * 384 * 64 + (size_t)(64 * h + 16 * nt + frl) * 128 + 8 * fql;
#pragma unroll
        for (int ks = 0; ks < 2; ++ks) { bw[ks] = *(const bf16x8*)(pbw + 32 * ks); ba[ks] = *(const bf16x8*)(pba + 32 * ks); }
#pragma unroll
        for (int ks = 0; ks < 4; ++ks) bg[ks] = *(const bf16x8*)(pbg + 32 * ks); }
    Sh8 s_wl, s_al, s_g0, s_g1;
#define RWP_ISSUE(cc) do { const int tok = launder(tok_), cs = launder(cs_); const bf16* prow = P + ((size_t)b * SEQ + (cc) * 64 + tok) * PCP; const int pofs = ((cc) * 64 + tok) > 0 ? PCP : 0; \
        sh8_issue(s_wl, prow, pofs, C_WWL + 8 * cs); sh8_issue(s_al, prow, pofs, C_WAL + 8 * cs); sh8_issue(s_g0, prow, pofs, C_WGL + 16 * cs); sh8_issue(s_g1, prow, pofs, C_WGL + 16 * cs + 8); } while (0)
    RWP_ISSUE(4 * cb);
    __syncthreads();
    float w0v[8], a0v[8], kkw[8], kaw[8], rk[8];
    ld8lf(PAR + 8 * cs_, w0v); ld8lf(PAR + 64 + 8 * cs_, a0v); ld8lf(PAR + 128 + 8 * cs_, kkw); ld8lf(PAR + 192 + 8 * cs_, kaw); ld8lf(PAR + 256 + 8 * cs_, rk);
    for (int ci = 0; ci < 4; ++ci) {
        const int c = 4 * cb + ci;
        const bool hp = (c * 64 + tok_) > 0;
        Sh8 s_r, s_k;
        { const int tok = launder(tok_), cs = launder(cs_); const bf16* prow = P + ((size_t)b * SEQ + c * 64 + tok) * PCP; const int pofs = hp ? PCP : 0;
            sh8_issue(s_r, prow, pofs, C_WR + 64 * h + 8 * cs); sh8_issue(s_k, prow, pofs, C_WK + 64 * h + 8 * cs); }
        {
            const int tok = tok_, cs = cs_;
            sh8_pin(s_wl); sh8_pin(s_al); sh8_pin(s_g0); sh8_pin(s_g1);
            float x[8], y[8];
            sh8_get(s_wl, hp, MU + 192 + 8 * cs, x);
#pragma unroll
            for (int j = 0; j < 8; ++j) y[j] = tanh_f(x[j]);
            *(LAS v4u*)(XW + tok * XW_LD + 8 * cs) = pack8(y);
            sh8_get(s_al, hp, MU + 256 + 8 * cs, x);
            *(LAS v4u*)(XA + tok * XW_LD + 8 * cs) = pack8(x);
            sh8_get(s_g0, hp, MU + 320 + 16 * cs, x);
#pragma unroll
            for (int j = 0; j < 8; ++j) y[j] = sigmoid_f(x[j]);
            *(LAS v4u*)(XG + tok * XG_LD + 16 * cs) = pack8(y);
            sh8_get(s_g1, hp, MU + 320 + 16 * cs + 8, x);
#pragma unroll
            for (int j = 0; j < 8; ++j) y[j] = sigmoid_f(x[j]);
            *(LAS v4u*)(XG + tok * XG_LD + 16 * cs + 8) = pack8(y);
        }
        __syncthreads();
        {
            f32x4 cw[2], ca[2], cg[2];
#pragma unroll
            for (int m = 0; m < 2; ++m) { cw[m] = (f32x4){0.f, 0.f, 0.f, 0.f}; ca[m] = cw[m]; cg[m] = cw[m];
                const int arow = 32 * mh + 16 * m + fr;
#pragma unroll
                for (int ks = 0; ks < 2; ++ks) { const bf16x8 fw = LDFRAG(XW + arow * XW_LD + 32 * ks + 8 * fq), fa = LDFRAG(XA + arow * XW_LD + 32 * ks + 8 * fq);
                    cw[m] = MFMA16(fw, bw[ks], cw[m]); ca[m] = MFMA16(fa, ba[ks], ca[m]); }
#pragma unroll
                for (int ks = 0; ks < 4; ++ks) { const bf16x8 fg = LDFRAG(XG + arow * XG_LD + 32 * ks + 8 * fq); cg[m] = MFMA16(fg, bg[ks], cg[m]); } }
#pragma unroll
            for (int m = 0; m < 2; ++m)
#pragma unroll
                for (int i = 0; i < 4; ++i) { const int o = (32 * mh + 16 * m + 4 * fq + i) * 64 + 16 * nt + fr; Wd[o] = cw[m][i]; AP[o] = ca[m][i]; G[o] = cg[m][i]; }
        }
        __syncthreads();
        float r8[8], kk[8], ka[8], kp[8], lw[8], cumw[8], bs;
        {
            const int tok = tok_, cs = cs_;
            float wacc[8], aacc[8], k8[8];
            ld8lf(Wd + tok * 64 + 8 * cs, wacc); ld8lf(AP + tok * 64 + 8 * cs, aacc);
            sh8_pin(s_r); sh8_pin(s_k);
            sh8_get(s_r, hp, MU + 8 * cs, r8); sh8_get(s_k, hp, MU + 64 + 8 * cs, k8);
            float ss = 0.f, bsum = 0.f;
#pragma unroll
            for (int j = 0; j < 8; ++j) { lw[j] = -0.6065306597f * sigmoid_f(wacc[j] + w0v[j]);     const float a = sigmoid_f(aacc[j] + a0v[j]);
                kk[j] = k8[j] * kkw[j]; ss += kk[j] * kk[j]; kp[j] = k8[j] * (1.0f + (a - 1.0f) * kaw[j]); ka[j] = a; bsum += r8[j] * kp[j] * rk[j]; }
            ss = red8(ss); bs = red8(bsum); const float inv = fminf(__builtin_amdgcn_rsqf(ss), 1e12f);
#pragma unroll
            for (int j = 0; j < 8; ++j) { kk[j] *= inv; ka[j] *= kk[j]; }
#pragma unroll
            for (int j = 0; j < 8; ++j) cumw[j] = lw[j];
#pragma unroll
            for (int d = 1; d < 8; d <<= 1) { float y[8];
#pragma unroll
                for (int j = 0; j < 8; ++j) y[j] = bperm(cumw[j], lane - 8 * d);
                asm volatile("" : "+v"(y[0]), "+v"(y[1]), "+v"(y[2]), "+v"(y[3]), "+v"(y[4]), "+v"(y[5]), "+v"(y[6]), "+v"(y[7]));
                if ((lane >> 3) >= d) {
#pragma unroll
                    for (int j = 0; j < 8; ++j) cumw[j] += y[j]; } }
            if ((lane >> 3) == 7) st8lf(WT + wave * 64 + 8 * cs, cumw);
        }
        __syncthreads();
        if (ci < 3) RWP_ISSUE(c + 1);
        {
            const int tok = tok_, cs = cs_; const int t16 = tok & 15, sc = tok >> 4;
            GAS unsigned char* tb = tiles + (size_t)(u * 32 + c) * TILE_B;
            float cum[8];
#pragma unroll
            for (int j = 0; j < 8; ++j) cum[j] = cumw[j];
            if (wave & 1) { float x[8]; ld8lf(WT + (wave - 1) * 64 + 8 * cs, x);
#pragma unroll
                for (int j = 0; j < 8; ++j) cum[j] += x[j]; }
            float ah[8], bh[8], kh[8], rh[8], gam[8], g8[8];
#pragma unroll
            for (int j = 0; j < 8; ++j) { gam[j] = __expf(cum[j]); const float ginv = __expf(-cum[j]), gprev = __expf(cum[j] - lw[j]);
                ah[j] = gprev * kk[j]; bh[j] = ka[j] * ginv; kh[j] = kp[j] * ginv; rh[j] = gam[j] * r8[j]; }
            ld8lf(G + tok * 64 + 8 * cs, g8);
            GAS v4u* t16p = (GAS v4u*)(tb + tok * 128 + cs * 16);
            t16p[0] = pack8(ah); t16p[512] = pack8(bh); t16p[1024] = pack8(kh); t16p[1536] = pack8(rh); t16p[2048] = pack8(g8);
            if (t16 == 15) { GAS f32x4* gp = (GAS f32x4*)(tb + TO_GT + (sc * 64 + 8 * cs) * 4); gp[0] = (f32x4){gam[0], gam[1], gam[2], gam[3]}; gp[1] = (f32x4){gam[4], gam[5], gam[6], gam[7]}; }
            if (cs == 0) *(GAS float*)(tb + TO_BS + tok * 4) = bs;
        }
    }
    __syncthreads();
}

constexpr int SO_AH = 0, SO_BH = 9216, SO_KH = 18432, SO_RH = 27648, SO_VB = 36864  , SO_GT = 55296, SO_AAB = 56320, SO_AAK = 60416, SO_ARBK = 65536, SO_TIN = 70656,
              SO_YL = 75776  , SO_GB = 108544  , SO_BS = 126976  , SO_PAR = 127488, SO_END = 128256;
static_assert(SO_END <= LDSCTL_OFF, "RWKV scan LDS map");
__device__ __forceinline__ void rwkv_scan_unit(Frame& F, const Args& A, int l, int b, int h) {
    LAS unsigned char* L = F.lds;
    LAS bf16* AH = (LAS bf16*)(L + SO_AH); LAS bf16* BH = (LAS bf16*)(L + SO_BH); LAS bf16* KH = (LAS bf16*)(L + SO_KH); LAS bf16* RH = (LAS bf16*)(L + SO_RH); LAS bf16* Vb2 = (LAS bf16*)(L + SO_VB);
    LAS float* GT = (LAS float*)(L + SO_GT); LAS float* AAB = (LAS float*)(L + SO_AAB); LAS bf16* AAK = (LAS bf16*)(L + SO_AAK); LAS bf16* ARBK = (LAS bf16*)(L + SO_ARBK); LAS bf16* TIN = (LAS bf16*)(L + SO_TIN);
    LAS float* Yl2 = (LAS float*)(L + SO_YL); LAS bf16* Gb2 = (LAS bf16*)(L + SO_GB); LAS float* BS2 = (LAS float*)(L + SO_BS); LAS float* PAR = (LAS float*)(L + SO_PAR);
    GAS unsigned char* wsu = (GAS unsigned char*)F.ws; asm volatile("" : "+s"(wsu)); const bf16* P = (const bf16*)(wsu + WS_P); bf16* Yg = (bf16*)(wsu + WS_A1);
    GAS unsigned char* tiles = (GAS unsigned char*)F.out; asm volatile("" : "+s"(tiles));
    const int u = 6 * b + h;
    int tid_ = FTID(F); asm volatile("" : "+v"(tid_)); const int tid = tid_, tok_ = tid >> 3, cs_ = tid & 7;
    const int lane = tid & 63, fr = lane & 15, fq = lane >> 4, wave = F.wave;
    if (tid < 192) { const int q = tid >> 6, ch = tid & 63; PAR[tid] = q == 0 ? A.in[9][(size_t)l * WCOLS + 768 + 64 * h + ch] : (q == 1 ? A.in[18] : A.in[19])[l * 384 + 64 * h + ch]; }
    for (int o = tid * 16; o < SO_YL - SO_AAK; o += NWAVES * 64 * 16) *(LAS v4u*)(L + SO_AAK + o) = (v4u){0u, 0u, 0u, 0u};
    f32x4 accS[4];
#pragma unroll
    for (int q = 0; q < 4; ++q) accS[q] = (f32x4){0.f, 0.f, 0.f, 0.f};
    v4u t_ah, t_bh, t_kh, t_rh, t_g, t_gt; Sh8 s_v; float t_bs;
#define RWS_ISSUE(cc) do { const int tok = launder(tok_), cs = launder(cs_); GAS unsigned char* tb = tiles + (size_t)(u * 32 + (cc)) * TILE_B; const GAS v4u* tp = (const GAS v4u*)(tb + tok * 128 + cs * 16); \
        t_ah = tp[0]; t_bh = tp[512]; t_kh = tp[1024]; t_rh = tp[1536]; t_g = tp[2048]; t_gt = *(const GAS v4u*)(tb + TO_GT + (tid & 63) * 16); t_bs = *(const GAS float*)(tb + TO_BS + tok * 4); \
        const bf16* prow = P + ((size_t)b * SEQ + (cc) * 64 + tok) * PCP; sh8_issue(s_v, prow, ((cc) * 64 + tok) > 0 ? PCP : 0, C_WV + 64 * h + 8 * cs); } while (0)
#define RWS_PHASE_D(cd, it0) do { const int pb_ = (cd) & 1; \
        _Pragma("unroll") for (int rep = 0; rep < 2; ++rep) { const int it = (it0) + 256 * rep, tok = it >> 3, cs = it & 7; const size_t row = (size_t)b * SEQ + (cd) * 64 + tok; \
            float y[8], lg[8], lb[8], g8[8], v8[8], o[8]; \
            ld8lf(Yl2 + pb_ * 4096 + tok * 64 + 8 * cs, y); ld8l(Gb2 + pb_ * 4608 + tok * TS + 8 * cs, g8); ld8l(Vb2 + pb_ * 4608 + tok * TS + 8 * cs, v8); const float bs = BS2[pb_ * 64 + tok]; \
            ld8lf(PAR + 64 + 8 * cs, lg); ld8lf(PAR + 128 + 8 * cs, lb); \
            float s1 = 0.f; _Pragma("unroll") for (int j = 0; j < 8; ++j) s1 += y[j]; \
            const float mu_ = red8(s1) * (1.0f / 64.0f); float s2 = 0.f; \
            _Pragma("unroll") for (int j = 0; j < 8; ++j) { y[j] -= mu_; s2 += y[j] * y[j]; } \
            const float rstd = 1.0f / sqrtf(red8(s2) * (1.0f / 64.0f) + 64e-5f); \
            _Pragma("unroll") for (int j = 0; j < 8; ++j) o[j] = (y[j] * rstd * lg[j] + lb[j] + bs * v8[j]) * g8[j]; \
            *(v4u*)(Yg + row * DM + Y_W + 64 * h + 8 * cs) = pack8(o); } } while (0)
    RWS_ISSUE(0);
    __syncthreads();
    for (int c = 0; c < SEQ / 64; ++c) {
        LAS bf16* Vb = Vb2 + (c & 1) * 4608; LAS float* Yl = Yl2 + (c & 1) * 4096;
        {
            const int tok = tok_, cs = cs_; const bool hp = (c * 64 + tok) > 0; float v8[8];
            asm volatile("" : "+v"(t_ah), "+v"(t_bh), "+v"(t_kh), "+v"(t_rh), "+v"(t_g), "+v"(t_gt), "+v"(t_bs)); sh8_pin(s_v);
            *(LAS v4u*)(AH + tok * TS + 8 * cs) = t_ah; *(LAS v4u*)(BH + tok * TS + 8 * cs) = t_bh; *(LAS v4u*)(KH + tok * TS + 8 * cs) = t_kh; *(LAS v4u*)(RH + tok * TS + 8 * cs) = t_rh;
            if (tid < 64) *(LAS v4u*)(GT + tid * 4) = t_gt;
            sh8_get(s_v, hp, PAR + 8 * cs, v8); *(LAS v4u*)(Vb + tok * TS + 8 * cs) = pack8(v8);
            *(LAS v4u*)(Gb2 + (c & 1) * 4608 + tok * TS + 8 * cs) = t_g; if (cs == 0) BS2[(c & 1) * 64 + tok] = t_bs;
            const int cn = c + 1 < SEQ / 64 ? c + 1 : c; RWS_ISSUE(cn);
        }
        __syncthreads();
        {
            const int sc = wave & 3;
#pragma unroll
            for (int x = 0; x < 3; ++x) { const int kind = (wave < 4) ? 0 : x + 1; if (wave < 4 && x > 0) break;
                const LAS bf16* A2 = ((kind & 2) ? RH : AH) + (16 * sc + fr) * TS + 8 * fq; const LAS bf16* B2 = ((kind & 1) ? KH : BH) + (16 * sc + fr) * TS + 8 * fq;
                bf16x8 fa0 = LDFRAG(A2), fa1 = LDFRAG(A2 + 32), fb0 = LDFRAG(B2), fb1 = LDFRAG(B2 + 32);
                asm volatile("" : "+v"(fa0), "+v"(fa1), "+v"(fb0), "+v"(fb1));
                f32x4 sm = (f32x4){0.f, 0.f, 0.f, 0.f};
                sm = MFMA16(fa0, fb0, sm); sm = MFMA16(fa1, fb1, sm);
#pragma unroll
                for (int i = 0; i < 4; ++i) { const int tt = 4 * fq + i, s_ = fr; const bool keep = (kind & 2) ? (s_ <= tt) : (s_ < tt); const float val = keep ? sm[i] : 0.f;
                    const int pp = 8 * (s_ >> 2) + (s_ & 3);
                    if (kind == 0) AAB[(sc * 16 + tt) * 16 + s_] = val; else if (kind == 1) AAK[(sc * 16 + tt) * US + pp + 4] = (bf16)f2bf(val);
                    else if (kind == 2) ARBK[(sc * 16 + tt) * US + pp] = (bf16)f2bf(val); else ARBK[(sc * 16 + tt) * US + pp + 4] = (bf16)f2bf(val); } }
            if (wave < 4) {
                const int cc = lane & 15; float xcol[16];
#pragma unroll
                for (int tt = 0; tt < 16; ++tt) { float arow[16];
#pragma unroll
                    for (int q = 0; q < 4; ++q) { const f32x4 a4 = *(const LAS f32x4*)(AAB + (sc * 16 + tt) * 16 + 4 * q); arow[4 * q] = a4.x; arow[4 * q + 1] = a4.y; arow[4 * q + 2] = a4.z; arow[4 * q + 3] = a4.w; }
                    float x = (tt == cc) ? 1.0f : 0.0f;
#pragma unroll
                    for (int s_ = 0; s_ < 16; ++s_) if (s_ < tt) x -= arow[s_] * xcol[s_];
                    xcol[tt] = x; }
#pragma unroll
                for (int tt = 0; tt < 16; ++tt) TIN[(sc * 16 + tt) * US + 8 * (cc >> 2) + (cc & 3)] = (bf16)f2bf(xcol[tt]);
            }
        }
        __syncthreads();
        if (wave >= 4) { if (c > 0) RWS_PHASE_D(c - 1, tid - 256); }
        else {
        bf16x8 fah[2], frh[2], abk[4], fak, frb, fti; f32x4 gt[4]; u32x2_t vtr;
#define RWS_LOADF(scn) do { const int t0_ = 16 * (scn); const LAS bf16* ahp = AH + (t0_ + fr) * TS + 4 * fq; const LAS bf16* rhp = RH + (t0_ + fr) * TS + 4 * fq; \
            _Pragma("unroll") for (int ks = 0; ks < 2; ++ks) { fah[ks] = frag2(*(const LAS u32x2_t*)(ahp + 32 * ks), *(const LAS u32x2_t*)(ahp + 32 * ks + 16)); frh[ks] = frag2(*(const LAS u32x2_t*)(rhp + 32 * ks), *(const LAS u32x2_t*)(rhp + 32 * ks + 16)); } \
            fak = LDFRAG(AAK + ((scn) * 16 + fr) * US + 8 * fq); frb = LDFRAG(ARBK + ((scn) * 16 + fr) * US + 8 * fq); fti = LDFRAG(TIN + ((scn) * 16 + fr) * US + 8 * fq); \
            vtr = tr4(Vb + (t0_ + 4 * fq) * TS + 16 * wave, TS, lane); \
            _Pragma("unroll") for (int kt = 0; kt < 4; ++kt) { abk[kt] = frag2(tr4(BH + (t0_ + 4 * fq) * TS + 16 * kt, TS, lane), tr4(KH + (t0_ + 4 * fq) * TS + 16 * kt, TS, lane)); gt[kt] = *(const LAS f32x4*)(GT + (scn) * 64 + 16 * kt + 4 * fq); } } while (0)
        RWS_LOADF(0);
#pragma unroll
        for (int sc = 0; sc < 4; ++sc) {
            const int t0 = 16 * sc;
            asm volatile("" : "+v"(fah[0]), "+v"(fah[1]), "+v"(frh[0]), "+v"(frh[1]), "+v"(fak), "+v"(frb), "+v"(fti), "+v"(vtr));
            asm volatile("" : "+v"(abk[0]), "+v"(abk[1]), "+v"(abk[2]), "+v"(abk[3]), "+v"(gt[0]), "+v"(gt[1]), "+v"(gt[2]), "+v"(gt[3]));
            const bf16x8 cfah0 = fah[0], cfah1 = fah[1], cfrh0 = frh[0], cfrh1 = frh[1], cfak = fak, cfrb = frb, cfti = fti, cabk0 = abk[0], cabk1 = abk[1], cabk2 = abk[2], cabk3 = abk[3];
            const f32x4 cgt0 = gt[0], cgt1 = gt[1], cgt2 = gt[2], cgt3 = gt[3]; const u32x2_t cvtr = vtr;
            if (sc < 3) RWS_LOADF(sc + 1);
            const u32x2_t z2 = (u32x2_t){0u, 0u};
            const bf16x8 bs0 = frag2(cvt4(accS[0]), cvt4(accS[1])), bs1 = frag2(cvt4(accS[2]), cvt4(accS[3]));
            f32x4 acc = (f32x4){0.f, 0.f, 0.f, 0.f}, accY = (f32x4){0.f, 0.f, 0.f, 0.f};
            acc = MFMA16(cfah0, bs0, acc); acc = MFMA16(cfah1, bs1, acc); acc = MFMA16(cfak, frag2(z2, cvtr), acc);
            accY = MFMA16(cfrh0, bs0, accY); accY = MFMA16(cfrh1, bs1, accY);
            const f32x4 uu = MFMA16(cfti, frag2(cvt4(-acc), z2), ((f32x4){0.f, 0.f, 0.f, 0.f}));
            const bf16x8 buv = frag2(cvt4(uu), cvtr);
            accY = MFMA16(cfrb, buv, accY);
#pragma unroll
            for (int i = 0; i < 4; ++i) Yl[(t0 + 4 * fq + i) * 64 + 16 * wave + fr] = accY[i];
            accS[0] = MFMA16(cabk0, buv, accS[0]); accS[0] = accS[0] * cgt0; accS[1] = MFMA16(cabk1, buv, accS[1]); accS[1] = accS[1] * cgt1;
            accS[2] = MFMA16(cabk2, buv, accS[2]); accS[2] = accS[2] * cgt2; accS[3] = MFMA16(cabk3, buv, accS[3]); accS[3] = accS[3] * cgt3;
        }
        }
        __syncthreads();
    }
    if (wave >= 4) RWS_PHASE_D(SEQ / 64 - 1, tid - 256);
    __syncthreads();
}
template <int CTRL, int ROWMASK> __device__ __forceinline__ float dpp_pull(float ident, float x) { return __builtin_bit_cast(float, __builtin_amdgcn_update_dpp(__builtin_bit_cast(int, ident), __builtin_bit_cast(int, x), CTRL, ROWMASK, 0xf, false)); }
__device__ __forceinline__ float scan_add64(float x, int) {
    x += dpp_pull<0x111, 0xf>(0.f, x); x += dpp_pull<0x112, 0xf>(0.f, x); x += dpp_pull<0x114, 0xf>(0.f, x); x += dpp_pull<0x118, 0xf>(0.f, x);
    x += dpp_pull<0x142, 0xa>(0.f, x); x += dpp_pull<0x143, 0xc>(0.f, x); return x;
}
__device__ __forceinline__ float scan_max64(float x, int) {
    const float NI = -3.0e38f;
    x = fmaxf(x, dpp_pull<0x111, 0xf>(NI, x)); x = fmaxf(x, dpp_pull<0x112, 0xf>(NI, x)); x = fmaxf(x, dpp_pull<0x114, 0xf>(NI, x)); x = fmaxf(x, dpp_pull<0x118, 0xf>(NI, x));
    x = fmaxf(x, dpp_pull<0x142, 0xa>(NI, x)); x = fmaxf(x, dpp_pull<0x143, 0xc>(NI, x)); return x;
}
template <bool ML> __device__ __forceinline__ void chunk_unit(Frame& F, const Args& A, int l, int b, int h) {
    LAS unsigned char* L = F.lds;
    constexpr int TSV = 88;
    LAS bf16* Qs = (LAS bf16*)L; LAS bf16* Ks = Qs + 64 * TS; LAS bf16* Kd = Ks + 64 * TS; LAS bf16* Pm = Kd + 64 * TS; LAS bf16* Vs = Pm + 64 * TS; LAS bf16* CT = Vs + 64 * TSV;
    LAS float* Hh = (LAS float*)(L + 59904); LAS float* DEN = (LAS float*)(L + 76288); LAS float* IG = (LAS float*)(L + 76544); LAS float* LF = IG + 64; LAS float* CW = LF + 64; LAS float* LNG = CW + 512;
    GAS unsigned char* wsu = (GAS unsigned char*)F.ws; asm volatile("" : "+s"(wsu));     const bf16* P = (const bf16*)(wsu + WS_P); bf16* Yg = (bf16*)(wsu + WS_A1);
    int tid_ = FTID(F); asm volatile("" : "+v"(tid_)); const int tid = tid_, tok_ = tid >> 3, cs_ = tid & 7;
    const int lane = tid & 63, fr = lane & 15, fq = lane >> 4, wave = F.wave;
    const int mt = wave & 3, half = wave >> 2, et0 = 2 * half; const bool aug = ML && half == 0;
    const float lgn = ML ? 0.f : log1pf(-exp2f(-5.0f - (float)h));
    for (int o = tid * 16; o < 64 * TSV * 2 + 80 * TS * 2; o += NWAVES * 64 * 16) *(LAS v4u*)((LAS unsigned char*)Vs + o) = (v4u){0u, 0u, 0u, 0u};
    __syncthreads();
    if (ML && tid < 64) Vs[tid * TSV + 64] = (bf16)0x3F80u;
    if (ML) { const float* convw = A.in[5] + (size_t)l * 4 * 512; const int jj = tid >> 7, c7 = tid & 127; CW[tid] = convw[jj * 512 + (c7 < 64 ? 64 * h + c7 : 256 + 64 * h + (c7 - 64))];
        if (tid < 64) LNG[tid] = A.in[8][l * 256 + 64 * h + tid]; }
    const float gbi = ML ? A.in[6][l * 4 + h] : 0.f, gbf = ML ? A.in[7][l * 4 + h] : 0.f;
    f32x4 accC[3];
#pragma unroll
    for (int x = 0; x < 3; ++x) accC[x] = (f32x4){0.f, 0.f, 0.f, 0.f};
    float mst = -1e30f;
    v4u rw[10]; unsigned rgate = 0u;
#define CU_ISSUE(cc) do { const int tok = launder(tok_), cs = launder(cs_); const int t = (cc) * 64 + tok; const bf16* prow = P + ((size_t)b * SEQ + t) * PCP; \
        if (ML) { _Pragma("unroll") for (int jj = 0; jj < 4; ++jj) { const int tt = t - 3 + jj; const bf16* pr = P + ((size_t)b * SEQ + (tt >= 0 ? tt : 0)) * PCP; \
                rw[2 * jj] = *(const v4u*)(pr + C_MQ + 64 * h + 8 * cs); rw[2 * jj + 1] = *(const v4u*)(pr + C_MK + 64 * h + 8 * cs); } \
            rw[8] = *(const v4u*)(prow + C_MV + 64 * h + 8 * cs); rw[9] = *(const v4u*)(prow + C_MO + 64 * h + 8 * cs); \
            rgate = (unsigned)prow[C_MGI + h] | ((unsigned)prow[C_MGF + h] << 16); } \
        else { const int i0 = 8 * (cs & 3); rw[0] = *(const v4u*)(prow + C_RQ + 64 * h + i0); rw[1] = *(const v4u*)(prow + C_RQ + 64 * h + 32 + i0); \
            rw[2] = *(const v4u*)(prow + C_RK + 64 * h + i0); rw[3] = *(const v4u*)(prow + C_RK + 64 * h + 32 + i0); rw[4] = *(const v4u*)(prow + C_RV + 64 * h + 8 * cs); rw[5] = *(const v4u*)(prow + C_RG + 64 * h + 8 * cs); } } while (0)
    CU_ISSUE(0);
    __syncthreads();
    for (int c = 0; c < SEQ / 64; ++c) {
        float k8[8]; v4u rgt;
        {
            const int tok = tok_, cs = cs_; const int t = c * 64 + tok;
            if (ML) asm volatile("" : "+v"(rw[0]), "+v"(rw[1]), "+v"(rw[2]), "+v"(rw[3]), "+v"(rw[4]), "+v"(rw[5]), "+v"(rw[6]), "+v"(rw[7]), "+v"(rw[8]), "+v"(rw[9]), "+v"(rgate));
            else asm volatile("" : "+v"(rw[0]), "+v"(rw[1]), "+v"(rw[2]), "+v"(rw[3]), "+v"(rw[4]), "+v"(rw[5]));
            float q8[8], vv[8];
            if (ML) {
#pragma unroll
                for (int j = 0; j < 8; ++j) { q8[j] = 0.f; k8[j] = 0.f; }
#pragma unroll
                for (int jj = 0; jj < 4; ++jj) { const float on = (t - 3 + jj) >= 0 ? 1.0f : 0.0f; float xq[8], xk[8], wq[8], wk[8];
                    unpack8(rw[2 * jj], xq); unpack8(rw[2 * jj + 1], xk); ld8lf(CW + jj * 128 + 8 * cs, wq); ld8lf(CW + jj * 128 + 64 + 8 * cs, wk);
#pragma unroll
                    for (int j = 0; j < 8; ++j) { q8[j] += on * wq[j] * xq[j]; k8[j] += on * wk[j] * xk[j]; } }
#pragma unroll
                for (int j = 0; j < 8; ++j) { q8[j] = silu2_f(q8[j]); k8[j] = silu2_f(k8[j]) * 0.125f; }
                unpack8(rw[8], vv); rgt = rw[9];
                if (cs == 0) { const float gi = bflo(rgate & 0xffffu) + gbi; const float xf = bfhi(rgate) + gbf;
                    IG[tok] = gi; LF[tok] = fminf(xf, 0.f) - __logf(1.0f + __expf(-fabsf(xf))); }
            } else {
                const int i0 = 8 * (cs & 3);
                float q1[8], q2[8], k1[8], k2[8];
                unpack8(rw[0], q1); unpack8(rw[1], q2); unpack8(rw[2], k1); unpack8(rw[3], k2); unpack8(rw[4], vv); rgt = rw[5];
#pragma unroll
                for (int j = 0; j < 8; ++j) {
                    const float theta = exp2f(-(float)(i0 + j) * (13.287712379549449f / 31.0f));
                    float rev = (float)t * theta * 0.15915494309189535f; rev -= floorf(rev);
                    const float sn = __builtin_amdgcn_sinf(rev), cn = __builtin_amdgcn_cosf(rev);
                    if (cs < 4) { q8[j] = q1[j] * cn - q2[j] * sn; k8[j] = k1[j] * cn - k2[j] * sn; }
                    else        { q8[j] = q1[j] * sn + q2[j] * cn; k8[j] = k1[j] * sn + k2[j] * cn; }
                    k8[j] *= 0.125f;
                }
            }
            { const int cn = c + 1 < SEQ / 64 ? c + 1 : c; CU_ISSUE(cn); }
            *(LAS v4u*)(Qs + tok * TS + 8 * cs) = pack8(q8); *(LAS v4u*)(Ks + tok * TS + 8 * cs) = pack8(k8);
            *(LAS v4u*)(Vs + tok * TSV + 8 * cs) = pack8(vv);
        }
        __syncthreads();
        float g, bj, iw, sw, dec, mrow = 0.f, mnew = 0.f;
        if (ML) { const float lf = LF[lane], ig = IG[lane]; const float bc = scan_add64(lf, lane); g = ig - bc; const float Gp = scan_max64(g, lane);
            const float bL = bperm(bc, 63), Gm = bperm(Gp, 63); const float mx = fmaxf(mst, Gp); mrow = bc + mx; bj = -mx; iw = __expf(bc + mst - mrow);
            mnew = bL + fmaxf(mst, Gm); sw = __expf(bL + g - mnew); dec = __expf(bL + mst - mnew); }
        else { bj = (float)lane * lgn; g = -bj; iw = __expf((float)(lane + 1) * lgn); sw = __expf((float)(63 - lane) * lgn); dec = __expf(64.0f * lgn); }
        {
            const float swt = bperm(sw, tok_); float kd[8];
#pragma unroll
            for (int j = 0; j < 8; ++j) kd[j] = k8[j] * swt;
            *(LAS v4u*)(Kd + tok_ * TS + 8 * cs_) = pack8(kd);
            const int st = wave >> 1;
            bf16x8 fk[2], fqa[2][2]; float gs[4], bjc[2];
#pragma unroll
            for (int ks = 0; ks < 2; ++ks) { fk[ks] = LDFRAG(Ks + (16 * st + fr) * TS + 32 * ks + 8 * fq);
#pragma unroll
                for (int jj = 0; jj < 2; ++jj) fqa[jj][ks] = LDFRAG(Qs + (16 * (2 * (wave & 1) + jj) + fr) * TS + 32 * ks + 8 * fq); }
#pragma unroll
            for (int i = 0; i < 4; ++i) gs[i] = bperm(g, 16 * st + 4 * fq + i);
#pragma unroll
            for (int jj = 0; jj < 2; ++jj) bjc[jj] = bperm(bj, 16 * (2 * (wave & 1) + jj) + fr);
            asm volatile("" : "+v"(fk[0]), "+v"(fk[1]), "+v"(fqa[0][0]), "+v"(fqa[0][1]), "+v"(fqa[1][0]), "+v"(fqa[1][1]), "+v"(gs[0]), "+v"(gs[1]), "+v"(gs[2]), "+v"(gs[3]), "+v"(bjc[0]), "+v"(bjc[1]));
#pragma unroll
            for (int jj = 0; jj < 2; ++jj) { const int jt = 2 * (wave & 1) + jj; u32x2_t w2; w2.x = 0u; w2.y = 0u;
                if (jt >= st) { f32x4 acc = (f32x4){0.f, 0.f, 0.f, 0.f};
#pragma unroll
                    for (int ks = 0; ks < 2; ++ks) acc = MFMA16(fk[ks], fqa[jj][ks], acc);
                    const int jc = 16 * jt + fr; float p[4];
#pragma unroll
                    for (int i = 0; i < 4; ++i) { const int s = 16 * st + 4 * fq + i; p[i] = (s <= jc) ? acc[i] * __expf(bjc[jj] + gs[i]) : 0.f; }
                    w2.x = pk2(p[0], p[1]); w2.y = pk2(p[2], p[3]); }
                *(LAS u32x2_t*)(Pm + (16 * jt + fr) * TS + 16 * st + 4 * fq) = w2; }
        }
        __syncthreads();
        {
            float iwr[4]; bf16x8 aq[2], ap[2], akd[2], bc[3][2], bv[3][2];
#pragma unroll
            for (int i = 0; i < 4; ++i) iwr[i] = bperm(iw, 16 * mt + 4 * fq + i);
#pragma unroll
            for (int ks = 0; ks < 2; ++ks) { aq[ks] = LDFRAG(Qs + (16 * mt + fr) * TS + 32 * ks + 8 * fq); ap[ks] = LDFRAG(Pm + (16 * mt + fr) * TS + 32 * ks + 8 * fq); akd[ks] = tr_frag(Kd + (32 * ks + 8 * fq) * TS + 16 * mt, TS, lane);
#pragma unroll
                for (int x = 0; x < 3; ++x) { const int et = (x == 2) ? (aug ? 4 : et0) : et0 + x; bc[x][ks] = LDFRAG(CT + (16 * et + fr) * TS + 32 * ks + 8 * fq); bv[x][ks] = tr_frag(Vs + (32 * ks + 8 * fq) * TSV + 16 * et, TSV, lane); } }
            asm volatile("" : "+v"(aq[0]), "+v"(aq[1]), "+v"(ap[0]), "+v"(ap[1]), "+v"(akd[0]), "+v"(akd[1]), "+v"(iwr[0]), "+v"(iwr[1]), "+v"(iwr[2]), "+v"(iwr[3]));
            asm volatile("" : "+v"(bc[0][0]), "+v"(bc[0][1]), "+v"(bc[1][0]), "+v"(bc[1][1]), "+v"(bc[2][0]), "+v"(bc[2][1]), "+v"(bv[0][0]), "+v"(bv[0][1]), "+v"(bv[1][0]), "+v"(bv[1][1]), "+v"(bv[2][0]), "+v"(bv[2][1]));
#pragma unroll
            for (int x = 0; x < 3; ++x) { if (x == 2 && !aug) break; const int et = (x == 2) ? 4 : et0 + x;
                f32x4 acc = (f32x4){0.f, 0.f, 0.f, 0.f};
#pragma unroll
                for (int ks = 0; ks < 2; ++ks) acc = MFMA16(aq[ks], bc[x][ks], acc);
#pragma unroll
                for (int i = 0; i < 4; ++i) acc[i] *= iwr[i];
#pragma unroll
                for (int ks = 0; ks < 2; ++ks) acc = MFMA16(ap[ks], bv[x][ks], acc);
                if (x < 2) {
#pragma unroll
                    for (int i = 0; i < 4; ++i) Hh[(16 * mt + 4 * fq + i) * 64 + 16 * et + fr] = acc[i]; }
                else if (fr == 0) {
#pragma unroll
                    for (int i = 0; i < 4; ++i) DEN[16 * mt + 4 * fq + i] = acc[i]; }
                accC[x] = accC[x] * dec;
#pragma unroll
                for (int ks = 0; ks < 2; ++ks) accC[x] = MFMA16(akd[ks], bv[x][ks], accC[x]);
            }
        }
        __syncthreads();
        {
#pragma unroll
            for (int x = 0; x < 3; ++x) { if (x == 2 && !aug) break; const int et = (x == 2) ? 4 : et0 + x;
                u32x2_t w2; w2.x = pk2(accC[x][0], accC[x][1]); w2.y = pk2(accC[x][2], accC[x][3]);
                *(LAS u32x2_t*)(CT + (16 * et + fr) * TS + 16 * mt + 4 * fq) = w2; }
            const int tok = launder(tok_), cs = launder(cs_); const size_t row = (size_t)b * SEQ + c * 64 + tok; const bf16* prow = P + row * PCP;
            float y[8], gt[8], o[8]; ld8lf(Hh + tok * 64 + 8 * cs, y); unpack8(rgt, gt);
            if (ML) { const float mr = bperm(mrow, tok_); const float sc_ = __builtin_amdgcn_rcpf(fmaxf(fabsf(DEN[tok]), __expf(-mr)));
#pragma unroll
                for (int j = 0; j < 8; ++j) y[j] *= sc_; }
            float s1 = 0.f;
#pragma unroll
            for (int j = 0; j < 8; ++j) s1 += y[j];
            const float mu = red8(s1) * (1.0f / 64.0f); float s2 = 0.f;
#pragma unroll
            for (int j = 0; j < 8; ++j) { y[j] -= mu; s2 += y[j] * y[j]; }
            const float rstd = 1.0f / sqrtf(red8(s2) * (1.0f / 64.0f) + 1e-5f);
            if (ML) { float gl[8]; ld8lf(LNG + 8 * cs, gl);
#pragma unroll
                for (int j = 0; j < 8; ++j) o[j] = sigmoid_f(gt[j]) * y[j] * rstd * gl[j]; }
            else {
#pragma unroll
                for (int j = 0; j < 8; ++j) o[j] = silu2_f(gt[j]) * y[j] * rstd; }
            *(v4u*)(Yg + row * DM + (ML ? Y_M : Y_R) + 64 * h + 8 * cs) = pack8(o);
            mst = mnew;
        }
    }
    __syncthreads();
}
__device__ __forceinline__ void mixer_phase(Frame& F, const Args& A, int l) {
    for (int u = F.vcu; u < 256; u += F.G) {
        if (u < 96) rwkv_scan_unit(F, A, l, u / 6, u % 6);
        else if (u < 192) chunk_unit<false>(F, A, l, (u - 96) / 6, (u - 96) % 6);
        else chunk_unit<true>(F, A, l, (u - 192) / 4, (u - 192) % 4);
        if (l == 0 && u >= 96 && F.G == 256) deferred_weights(F, A, u - 96);
    }
}

__global__ void __launch_bounds__(NWAVES * 64, 2) hyb_fwd(Args args) {
    extern __shared__ __attribute__((aligned(16))) unsigned char lds[];
    Frame F;
    F.lds = (LAS unsigned char*)lds;
    F.MISC = (volatile LAS unsigned*)(F.lds + MISC_OFF);
    F.wave = __builtin_amdgcn_readfirstlane(threadIdx.x >> 6);
    F.G = gridDim.x; { const int bx = blockIdx.x; F.vcu = (F.G % 8 == 0) ? (bx % 8) * (F.G / 8) + bx / 8 : bx; }
    F.ws = args.ws; F.out = args.out; F.ctl = (gu32*)(args.ws + WS_CTL);
    for (int u = threadIdx.x; u < (LDS_BYTES - LDSCTL_OFF) / 4; u += NWAVES * 64) ((LAS unsigned*)(F.lds + LDSCTL_OFF))[u] = 0u;
    __syncthreads();
    XcdBarrier bar; bar.bar = (unsigned*)(F.ctl + CW_BAR); bar.x = 0; bar.st = nullptr;
    if (N_LAUNCHES == 1) bar = xcd_barrier_post((unsigned*)(F.ctl + CW_BAR), F.MISC + 8);
#define GRID_BAR() do { if (N_LAUNCHES == 1) xcd_barrier(bar, F.wave == 0 && flane() == 0); } while (0)
    const int lo = args.ph_lo, hi = args.ph_hi;
#define IN(k) (N_LAUNCHES == 1 || (lo <= (k) && (k) < hi))
#define BOTH(k) (IN(k) && IN((k) + 1))

    if (IN(0)) { p0_prologue(F, args); if (BOTH(0)) GRID_BAR(); }
    for (int l = 0; l < DEPTH; ++l) {
        const int pb = 1 + 5 * l;
        GAS unsigned char* wsl = (GAS unsigned char*)args.ws; asm volatile("" : "+s"(wsl));
        float* rss = (float*)(wsl + WS_RSS); bf16* A1 = (bf16*)(wsl + WS_A1); bf16* XB = (bf16*)(wsl + WS_XB); bf16* XB2 = (bf16*)(wsl + WS_XB2); bf16* PB = (bf16*)(wsl + WS_P);
        if (IN(pb)) {
            pg8::Gemm g{XB, (const bf16*)(wsl + WS_WIN) + (size_t)l * PCP * DM, M, PCP, DM}; pg8::StaticOrder S; S.init(M, PCP, F.G, (int)blockIdx.x);
            pg8::EpiP E{PB, PCP, rss + (size_t)(2 * l) * M};
            pg8::gemm_phase<pg8::EpiP, pg8::StaticOrder, true, true>(F.lds + RING_OFF, g, S, E, F.wave);
            if (BOTH(pb)) GRID_BAR();
        }
        if (IN(pb + 1)) {
            for (int k = F.vcu; k < 768; k += F.G) rwkv_prep_block(F, args, l, k >> 3, k & 7);
            GRID_BAR();
            mixer_phase(F, args, l); if (BOTH(pb + 1)) GRID_BAR();
        }
        if (IN(pb + 2)) {
            pg8::Gemm g{A1, (const bf16*)(wsl + WS_WOUT) + (size_t)l * DM * DM, M, DM, DM}; pg8::StaticOrder S; S.init(M, DM, F.G, (int)blockIdx.x);
            pg8::EpiRes E{XB, XB2, rss + (size_t)(2 * l + 1) * M, DM};
            pg8::gemm_phase<pg8::EpiRes, pg8::StaticOrder, true, true>(F.lds + RING_OFF, g, S, E, F.wave);
            if (BOTH(pb + 2)) GRID_BAR();
        }
        if (IN(pb + 3)) {
            pg8::Gemm g{XB2, (const bf16*)(wsl + WS_WGU) + (size_t)l * NGU * DM, M, NGU, DM}; pg8::StaticOrder S; S.init(M, NGU, F.G, (int)blockIdx.x);
            pg8::EpiSwiGLU E{PB, DFF, rss + (size_t)(2 * l + 1) * M};
            pg8::gemm_phase<pg8::EpiSwiGLU, pg8::StaticOrder, true, true>(F.lds + RING_OFF, g, S, E, F.wave);
            if (BOTH(pb + 3)) GRID_BAR();
        }
        if (IN(pb + 4)) {
            pg8::Gemm g{PB, (const bf16*)(wsl + WS_WDN) + (size_t)l * DM * DFF, M, DM, DFF}; pg8::StaticOrder S; S.init(M, DM, F.G, (int)blockIdx.x);
            if (l < DEPTH - 1) {
                pg8::EpiRes E{XB2, XB, rss + (size_t)(2 * l + 2) * M, DM};
                pg8::gemm_phase<pg8::EpiRes, pg8::StaticOrder, true, true>(F.lds + RING_OFF, g, S, E, F.wave);
                if (BOTH(pb + 4)) GRID_BAR();
            } else {
                pg8::EpiResFinal E{XB2, (float*)args.out, rss + (size_t)(2 * l + 2) * M, args.in[4], (unsigned*)(wsl + WS_CTL) + CW_PANEL, DM};
                pg8::gemm_phase<pg8::EpiResFinal, pg8::StaticOrder, true, true>(F.lds + RING_OFF, g, S, E, F.wave);
            }
        }
    }
#undef IN
#undef BOTH
}

extern "C" void kernel_launch(void* const* d_in, const int* in_sizes, int n_in, void* d_out, int out_size, void* d_ws, size_t ws_size, hipStream_t stream) {
    static int grid = 0;
    if (grid == 0) {
        if (n_in != 24 || in_sizes[0] != M * DM || out_size != M * DM || ws_size < WS_END) { fprintf(stderr, "kernel_launch: unexpected shapes: n_in %d in0 %d out %d ws %zu (need %zu)\n", n_in, n_in > 0 ? in_sizes[0] : -1, out_size, ws_size, (size_t)WS_END); grid = -1; return; }
        int dev = 0, cus = 0;
        if (hipGetDevice(&dev) != hipSuccess || hipDeviceGetAttribute(&cus, hipDeviceAttributeMultiprocessorCount, dev) != hipSuccess) { grid = -1; return; }
        if (hipFuncSetAttribute((const void*)hyb_fwd, hipFuncAttributeMaxDynamicSharedMemorySize, LDS_BYTES) != hipSuccess) { fprintf(stderr, "kernel_launch: hipFuncSetAttribute failed\n"); grid = -1; return; }
        int per_cu = 0;
        if (hipOccupancyMaxActiveBlocksPerMultiprocessor(&per_cu, (const void*)hyb_fwd, NWAVES * 64, LDS_BYTES) != hipSuccess || per_cu < 1) fprintf(stderr, "kernel_launch: occupancy query says %d\n", per_cu);
        (void)hipGetLastError();
        grid = cus;
    }
    if (grid < 0) return;
    if (hipMemsetAsync((char*)d_ws + WS_CTL, 0, CTL_ZERO_BYTES, stream) != hipSuccess) return;
    Args a{};
    for (int i = 0; i < 24; ++i) a.in[i] = (const float*)d_in[i];
    a.out = (float*)d_out; a.ws = (unsigned char*)d_ws;
    for (int li = 0; li < N_LAUNCHES; ++li) {
        a.ph_lo = (N_LAUNCHES == 1) ? 0 : li; a.ph_hi = (N_LAUNCHES == 1) ? NPH : li + 1; a.li = li;
        hipLaunchKernelGGL(hyb_fwd, dim3(grid), dim3(NWAVES * 64), LDS_BYTES, stream, a);
        if (hipPeekAtLastError() != hipSuccess) { fprintf(stderr, "kernel_launch: launch %d failed\n", li); break; }
    }
}
```

```cpp
#include <hip/hip_runtime.h>
#include <cstdio>
#include <cstdint>
#include <cmath>
#define MK_N_LAUNCHES 1
constexpr size_t PU_M = 0, PU_R = PU_M + (size_t)16 * 4 * 2048 * 256, PU_W = PU_R + (size_t)16 * 6 * 2048 * 256, PU_L = PU_W + (size_t)16 * 6 * 2048 * 192, PU_G = PU_L + (size_t)16 * 2048 * 256, PU_END = PU_G + (size_t)16 * 2048 * 8;
static_assert(PU_END * 2 <= 256u * (1u << 20), "unit-major p fits its 256 MiB region");
namespace pg8 {
#define PG8_LAS __attribute__((address_space(3)))
typedef unsigned short bf16_t;
typedef short bf16x8 __attribute__((ext_vector_type(8)));
typedef float f32x4 __attribute__((ext_vector_type(4)));
typedef unsigned u32x4 __attribute__((ext_vector_type(4)));
constexpr int BM = 256, BK = 64, HALF = 128, HTB = HALF * BK * 2  , STAGE_BYTES = 8 * HTB, NXCD = 8, WGM = 8;

__host__ __device__ __forceinline__ int lds_byte(int r, int c) { const int st = (r >> 4) * 2 + (c >> 5), rr = r & 15, cc = c & 31, ob = rr * 64 + cc * 2; return st * 1024 + (ob ^ (((ob >> 9) & 1) << 5)); }
__host__ __device__ __forceinline__ void stage_rc(int b, int& R, int& C) { const int st = b / 1024, sb = b % 1024, swz = sb ^ (((sb >> 9) & 1) << 5); R = (st >> 1) * 16 + swz / 64; C = (st & 1) * 32 + (swz % 64) / 2; }
__host__ __device__ __forceinline__ int perm32(int rho) { const int n = rho >> 4, i = rho & 15; return 8 * (i >> 2) + 4 * n + (i & 3); }

struct Unit { int pm, pn; };
struct Gemm { const bf16_t* A; const bf16_t* Bt; int M, N, K; };

struct StaticOrder {
    int nM, nN, nwg, G, c;
    __host__ __device__ void init(int M, int N, int G_, int c_) { nM = M / BM; nN = N / BM; nwg = nM * nN; G = G_; c = c_; }
    __host__ __device__ bool next(int i, Unit& u) const {
        const long L = (long)i * G + c; if (L >= nwg) return false;
        int wgid = (int)L; { const int q = nwg / NXCD, r = nwg % NXCD, xcd = wgid % NXCD, off = wgid / NXCD; wgid = (xcd < r ? xcd * (q + 1) : r * (q + 1) + (xcd - r) * q) + off; }
        const int nig = WGM * nN, gid = wgid / nig, fm = gid * WGM, gsz = (nM - fm) < WGM ? (nM - fm) : WGM;
        u.pm = fm + ((wgid % nig) % gsz); u.pn = (wgid % nig) / gsz; return true;
    }
    __device__ __forceinline__ void a_ready(const Unit&) const {}
    __device__ __forceinline__ void done(const Unit&) const {}
};
__device__ __forceinline__ unsigned cvt_pk_bf16(float lo, float hi) { unsigned r; asm volatile("v_cvt_pk_bf16_f32 %0, %1, %2" : "=v"(r) : "v"(lo), "v"(hi)); return r; }
typedef float f32x2 __attribute__((ext_vector_type(2)));
typedef unsigned u32x2 __attribute__((ext_vector_type(2)));
constexpr float RMS_EPS_F = 1e-6f;
constexpr float RSS_SCALE = 16384.0f;
__device__ __forceinline__ float row_rstd(const float* rowss, int row) { return rowss ? __builtin_amdgcn_rsqf((float)((const unsigned*)rowss)[row] * (1.0f / (RSS_SCALE * 1024.0f)) + RMS_EPS_F) : 1.0f; }
__device__ __forceinline__ void st16_wt(void* p, const u32x4 v) { asm volatile("global_store_dwordx4 %0, %1, off sc1\n\ts_nop 1" :: "v"(p), "v"(v) : "memory"); }
constexpr int RSSTAB_OFF = 131072;
__device__ __forceinline__ float rstd_of(unsigned ss) { return __builtin_amdgcn_rsqf((float)ss * (1.0f / (RSS_SCALE * 1024.0f)) + RMS_EPS_F); }
__device__ __forceinline__ float silu_f(float g) { return g * __builtin_amdgcn_rcpf(1.0f + __expf(-g)); }

struct EpiP {
    static constexpr bool PERM = true, AFTER_DRAIN = false, RSS_LDS = true;
    bf16_t* O; const float* rowss;
    __device__ __forceinline__ void operator()(const f32x4 (&acc)[2][2][4][2], const Unit& u, int wr, int wc, int fr, int fq, const PG8_LAS unsigned* rtab) const {
        int col0_ = u.pn * BM + wc * 32 + 8 * fq; asm volatile("" : "+v"(col0_));
        const int row0 = u.pm * BM + wr * 64 + fr, col0 = col0_;
        unsigned rv[2][4];
#pragma unroll
        for (int ai = 0; ai < 2; ++ai)
#pragma unroll
            for (int m = 0; m < 4; ++m) rv[ai][m] = rtab[wr * 64 + fr + ai * HALF + m * 16];
        asm volatile("" : "+v"(rv[0][0]), "+v"(rv[0][1]), "+v"(rv[0][2]), "+v"(rv[0][3]), "+v"(rv[1][0]), "+v"(rv[1][1]), "+v"(rv[1][2]), "+v"(rv[1][3]));
        unsigned cb[2], nh[2], hh[2], rwd[2]; bool ok[2];
#pragma unroll
        for (int bj = 0; bj < 2; ++bj) { const int cw = __builtin_amdgcn_readfirstlane(u.pn * BM + bj * HALF + wc * 32); unsigned cb_, nh_, hh_, rw_;
            if (cw < 1024)      { nh_ = 4; hh_ = (cw >> 6) & 3; rw_ = 256; cb_ = (unsigned)PU_M + 64 * (cw >> 8) + (cw & 63); }
            else if (cw < 2560) { const int o = cw - 1024, a = o / 384; nh_ = 6; hh_ = (o - 384 * a) >> 6; rw_ = 256; cb_ = (unsigned)PU_R + 64 * a + (o & 63); }
            else if (cw < 3712) { const int o = cw - 2560, a = o / 384; nh_ = 6; hh_ = (o - 384 * a) >> 6; rw_ = 192; cb_ = (unsigned)PU_W + 64 * a + (o & 63); }
            else if (cw < 3968) { nh_ = 1; hh_ = 0; rw_ = 256; cb_ = (unsigned)PU_L + (cw - 3712); }
            else if (cw < 4000) { nh_ = 1; hh_ = 0; rw_ = 8; cb_ = (unsigned)PU_G; }
            else                { nh_ = 1; hh_ = 0; rw_ = 0; cb_ = 0; }
            cb[bj] = cb_ + 8 * fq; nh[bj] = nh_; hh[bj] = hh_; rwd[bj] = rw_; ok[bj] = rw_ > 0 && (cw != 3968 || fq == 0); }
#pragma unroll
        for (int ai = 0; ai < 2; ++ai)
#pragma unroll
            for (int m = 0; m < 4; ++m) { const int row = row0 + ai * HALF + m * 16, bb = row >> 11, t = row & 2047; const float rs = rstd_of(rv[ai][m]);
#pragma unroll
                for (int bj = 0; bj < 2; ++bj) { const f32x4 v0 = acc[ai][bj][m][0] * rs, v1 = acc[ai][bj][m][1] * rs;
                    u32x4 w; w.x = cvt_pk_bf16(v0[0], v0[1]); w.y = cvt_pk_bf16(v0[2], v0[3]); w.z = cvt_pk_bf16(v1[0], v1[1]); w.w = cvt_pk_bf16(v1[2], v1[3]);
                    if (ok[bj]) st16_wt(O + (size_t)(cb[bj] + (((unsigned)bb * nh[bj] + hh[bj]) * 2048u + (unsigned)t) * rwd[bj]), w); } }
    }
};
struct EpiSwiGLU {
    static constexpr bool PERM = true, AFTER_DRAIN = false, RSS_LDS = true; static constexpr int NVM = 9;
    bf16_t* H; int ldh; const float* rowss;
    __device__ __forceinline__ void operator()(const f32x4 (&acc)[2][2][4][2], const Unit& u, int wr, int wc, int fr, int fq, const PG8_LAS unsigned* rtab) const {
        const int row0 = u.pm * BM + wr * 64 + fr, col0 = u.pn * HALF + wc * 32 + 8 * fq;
        unsigned rv[2][4];
#pragma unroll
        for (int ai = 0; ai < 2; ++ai)
#pragma unroll
            for (int m = 0; m < 4; ++m) rv[ai][m] = rtab[wr * 64 + fr + ai * HALF + m * 16];
        asm volatile("" : "+v"(rv[0][0]), "+v"(rv[0][1]), "+v"(rv[0][2]), "+v"(rv[0][3]), "+v"(rv[1][0]), "+v"(rv[1][1]), "+v"(rv[1][2]), "+v"(rv[1][3]));
#pragma unroll
        for (int ai = 0; ai < 2; ++ai)
#pragma unroll
            for (int m = 0; m < 4; ++m) { const int row = row0 + ai * HALF + m * 16; const float rs = rstd_of(rv[ai][m]);
                float h[8];
#pragma unroll
                for (int n = 0; n < 2; ++n)
#pragma unroll
                    for (int j = 0; j < 4; ++j) { const float g = acc[ai][0][m][n][j] * rs, up = acc[ai][1][m][n][j] * rs; h[4 * n + j] = silu_f(g) * up; }
                u32x4 w; w.x = cvt_pk_bf16(h[0], h[1]); w.y = cvt_pk_bf16(h[2], h[3]); w.z = cvt_pk_bf16(h[4], h[5]); w.w = cvt_pk_bf16(h[6], h[7]);
                st16_wt(H + (size_t)row * ldh + col0, w); }
    }
};
struct EpiRes {
    static constexpr bool PERM = true, AFTER_DRAIN = false, RSS_LDS = false; static constexpr int NVM = 24;
    const bf16_t* Xin; bf16_t* X; float* rowss; int ldc;
    __device__ __forceinline__ void operator()(const f32x4 (&acc)[2][2][4][2], const Unit& u, int wr, int wc, int fr, int fq) const {
        const int row0 = u.pm * BM + wr * 64 + fr, col0 = u.pn * BM + wc * 32 + 8 * fq, ln = 16 * fq + fr;
        u32x4 bs[2][4][2];
#pragma unroll
        for (int ai = 0; ai < 2; ++ai)
#pragma unroll
            for (int m = 0; m < 4; ++m) { const int r_ = row0 + ai * HALF + m * 16; const bf16_t* rowi = Xin + (unsigned)(((r_ >> 11) * 32768 + (r_ & 2047)) * 64) + (unsigned)((col0 >> 6) * 131072 + (col0 & 63));
#pragma unroll
                for (int bj = 0; bj < 2; ++bj) bs[ai][m][bj] = __builtin_nontemporal_load((const u32x4*)(rowi + bj * 2 * 131072)); }
#pragma unroll
        for (int ai = 0; ai < 2; ++ai)
#pragma unroll
            for (int m = 0; m < 4; ++m) asm volatile("" : "+v"(bs[ai][m][0]), "+v"(bs[ai][m][1]));
        float ssv[2][4];
#pragma unroll
        for (int ai = 0; ai < 2; ++ai)
#pragma unroll
            for (int m = 0; m < 4; ++m) { const int row = row0 + ai * HALF + m * 16; bf16_t* rowp = X + (unsigned)(((row >> 11) * 32768 + (row & 2047)) * 64) + (unsigned)((col0 >> 6) * 131072 + (col0 & 63)); float ss = 0.f;
#pragma unroll
                for (int bj = 0; bj < 2; ++bj) { float o[8];
#pragma unroll
                    for (int q = 0; q < 4; ++q) { const unsigned w = bs[ai][m][bj][q]; o[2 * q] = __builtin_bit_cast(float, w << 16) + acc[ai][bj][m][q >> 1][2 * (q & 1)]; o[2 * q + 1] = __builtin_bit_cast(float, w & 0xffff0000u) + acc[ai][bj][m][q >> 1][2 * (q & 1) + 1]; }
#pragma unroll
                    for (int q = 0; q < 8; ++q) ss += o[q] * o[q];
                    u32x4 w; w.x = cvt_pk_bf16(o[0], o[1]); w.y = cvt_pk_bf16(o[2], o[3]); w.z = cvt_pk_bf16(o[4], o[5]); w.w = cvt_pk_bf16(o[6], o[7]);
                    *(u32x4*)(rowp + bj * 2 * 131072) = w; }
                ssv[ai][m] = ss; }
        float t[2][4];
#pragma unroll
        for (int ai = 0; ai < 2; ++ai)
#pragma unroll
            for (int m = 0; m < 4; ++m) t[ai][m] = __builtin_bit_cast(float, __builtin_amdgcn_ds_bpermute((ln ^ 16) << 2, __builtin_bit_cast(int, ssv[ai][m])));
        asm volatile("" : "+v"(t[0][0]), "+v"(t[0][1]), "+v"(t[0][2]), "+v"(t[0][3]), "+v"(t[1][0]), "+v"(t[1][1]), "+v"(t[1][2]), "+v"(t[1][3]));
#pragma unroll
        for (int ai = 0; ai < 2; ++ai)
#pragma unroll
            for (int m = 0; m < 4; ++m) { ssv[ai][m] += t[ai][m]; t[ai][m] = __builtin_bit_cast(float, __builtin_amdgcn_ds_bpermute((ln ^ 32) << 2, __builtin_bit_cast(int, ssv[ai][m]))); }
        asm volatile("" : "+v"(t[0][0]), "+v"(t[0][1]), "+v"(t[0][2]), "+v"(t[0][3]), "+v"(t[1][0]), "+v"(t[1][1]), "+v"(t[1][2]), "+v"(t[1][3]));
#pragma unroll
        for (int ai = 0; ai < 2; ++ai)
#pragma unroll
            for (int m = 0; m < 4; ++m) if (fq == 0) atomicAdd((unsigned*)rowss + row0 + ai * HALF + m * 16, (unsigned)((ssv[ai][m] + t[ai][m]) * RSS_SCALE + 0.5f));
    }
};

struct EpiResFinal {
    static constexpr bool PERM = true, AFTER_DRAIN = false, RSS_LDS = false; static constexpr int NVM = 0;
    const bf16_t* Xin; float* out; float* rowss; const float* gain; unsigned* cnt; int ldc;
    __device__ __forceinline__ void operator()(const f32x4 (&acc)[2][2][4][2], const Unit& u, int wr, int wc, int fr, int fq) const {
        const int row0 = u.pm * BM + wr * 64 + fr, col0 = u.pn * BM + wc * 32 + 8 * fq, ln = 16 * fq + fr;
        u32x4 bs[2][4][2];
#pragma unroll
        for (int ai = 0; ai < 2; ++ai)
#pragma unroll
            for (int m = 0; m < 4; ++m) { const int r_ = row0 + ai * HALF + m * 16; const bf16_t* rowi = Xin + (unsigned)(((r_ >> 11) * 32768 + (r_ & 2047)) * 64) + (unsigned)((col0 >> 6) * 131072 + (col0 & 63));
#pragma unroll
                for (int bj = 0; bj < 2; ++bj) bs[ai][m][bj] = __builtin_nontemporal_load((const u32x4*)(rowi + bj * 2 * 131072)); }
#pragma unroll
        for (int ai = 0; ai < 2; ++ai)
#pragma unroll
            for (int m = 0; m < 4; ++m) asm volatile("" : "+v"(bs[ai][m][0]), "+v"(bs[ai][m][1]));
        f32x4 o[2][4][2][2];
#pragma unroll
        for (int ai = 0; ai < 2; ++ai)
#pragma unroll
            for (int m = 0; m < 4; ++m) { const int row = row0 + ai * HALF + m * 16; float ss = 0.f;
#pragma unroll
                for (int bj = 0; bj < 2; ++bj)
#pragma unroll
                    for (int n = 0; n < 2; ++n) { const unsigned w0 = bs[ai][m][bj][2 * n], w1 = bs[ai][m][bj][2 * n + 1];
                        const f32x4 x = (f32x4){__builtin_bit_cast(float, w0 << 16), __builtin_bit_cast(float, w0 & 0xffff0000u), __builtin_bit_cast(float, w1 << 16), __builtin_bit_cast(float, w1 & 0xffff0000u)};
                        const f32x4 v = x + acc[ai][bj][m][n]; o[ai][m][bj][n] = v; ss += v[0] * v[0] + v[1] * v[1] + v[2] * v[2] + v[3] * v[3]; }
                ss += __builtin_bit_cast(float, __builtin_amdgcn_ds_bpermute((ln ^ 16) << 2, __builtin_bit_cast(int, ss))); ss += __builtin_bit_cast(float, __builtin_amdgcn_ds_bpermute((ln ^ 32) << 2, __builtin_bit_cast(int, ss)));
                if (fq == 0) atomicAdd((unsigned*)rowss + row, (unsigned)(ss * RSS_SCALE + 0.5f)); }
        f32x4 gv[2][2];
#pragma unroll
        for (int bj = 0; bj < 2; ++bj)
#pragma unroll
            for (int n = 0; n < 2; ++n) gv[bj][n] = *(const f32x4*)(gain + col0 + bj * HALF + 4 * n);
        asm volatile("s_waitcnt vmcnt(0)" ::: "memory");
        __builtin_amdgcn_s_barrier();
        if (wr == 0 && wc == 0 && ln == 0) { unsigned* c = cnt + 16 * u.pm; (void)__hip_atomic_fetch_add(c, 1u, __ATOMIC_RELAXED, __HIP_MEMORY_SCOPE_AGENT);
            unsigned sp = 0; while (__hip_atomic_load(c, __ATOMIC_RELAXED, __HIP_MEMORY_SCOPE_AGENT) < 4u && ++sp < (1u << 22)) __builtin_amdgcn_s_sleep(1); }
        __builtin_amdgcn_s_barrier();
#pragma unroll
        for (int ai = 0; ai < 2; ++ai)
#pragma unroll
            for (int m = 0; m < 4; ++m) { const int row = row0 + ai * HALF + m * 16;
                const float rs = __builtin_amdgcn_rsqf((float)__hip_atomic_load((unsigned*)rowss + row, __ATOMIC_RELAXED, __HIP_MEMORY_SCOPE_AGENT) * (1.0f / (RSS_SCALE * 1024.0f)) + RMS_EPS_F);
                float* rowp = out + (size_t)row * ldc + col0;
#pragma unroll
                for (int bj = 0; bj < 2; ++bj)
#pragma unroll
                    for (int n = 0; n < 2; ++n) *(f32x4*)(rowp + bj * HALF + 4 * n) = o[ai][m][bj][n] * rs * gv[bj][n]; }
    }
};
template <class Epi, class Sched, bool ALIGN_EPI = false, bool SP2 = false, bool A_UM = false>
__device__ __forceinline__ void gemm_phase(PG8_LAS unsigned char* lds, const Gemm g, const Sched& S, const Epi& E, const int wave_id) {
    int lane_; asm volatile("v_mbcnt_lo_u32_b32 %0, -1, 0\n\tv_mbcnt_hi_u32_b32 %0, -1, %0" : "=v"(lane_)); int tid_ = wave_id * 64 + lane_;
    const int tid = tid_, wid = __builtin_amdgcn_readfirstlane(tid >> 6), lane = tid & 63, wr = wid >> 2, wc = wid & 3, fr = lane & 15, fq = lane >> 4;
    const int K = g.K, nt = K / BK;
    unsigned voffA[2], voffB[2];
#pragma unroll
    for (int i = 0; i < 2; ++i) { int R, C; stage_rc(tid * 16 + i * 8192, R, C); const int Rb = Epi::PERM ? ((R & ~31) + perm32(R & 31)) : R;
        voffA[i] = (unsigned)(R * (A_UM ? 64 : K) + C) * 2u; voffB[i] = (unsigned)(Rb * K + C) * 2u; }
    const size_t kstep = (size_t)(BK * 2);
    const size_t hstep = (size_t)HALF * K * 2;
    const size_t tstep = 2 * hstep;
    const size_t kstepA = A_UM ? (size_t)2048 * 64 * 2 : kstep, hstepA = A_UM ? (size_t)HALF * 64 * 2 : hstep;
#define PG8_AOFF(pm) (A_UM ? ((size_t)((pm) >> 3) * 16 * 2048 + (size_t)((pm) & 7) * 256) * 128 : (size_t)(pm) * tstep)
    const unsigned ldsw = (unsigned)wid * 1024u;
    const int aoff = lds_byte(wr * 64 + fr, fq * 8), boff = lds_byte(wc * 32 + fr, fq * 8);
#define PG8_SA(b, h) (((b) * 2 + (h)) * HTB)
#define PG8_SB(b, h) ((4 + (b) * 2 + (h)) * HTB)
#define PG8_STAGE(bufoff, gbase, voff) do { _Pragma("unroll") for (int _i = 0; _i < 2; ++_i) \
        __builtin_amdgcn_global_load_lds((const unsigned*)((const char*)(gbase) + (voff)[_i]), (PG8_LAS unsigned*)(lds + (bufoff) + ldsw + _i * 8192), 16, 0, 0); } while (0)
#define PG8_LDA(dst, b, h) do { _Pragma("unroll") for (int m = 0; m < 4; ++m) _Pragma("unroll") for (int k = 0; k < 2; ++k) dst[m][k] = *(const PG8_LAS bf16x8*)(lds + PG8_SA(b, h) + aoff + m * 2048 + k * 1024); } while (0)
#define PG8_LDB(dst, b, h) do { _Pragma("unroll") for (int n = 0; n < 2; ++n) _Pragma("unroll") for (int k = 0; k < 2; ++k) dst[n][k] = *(const PG8_LAS bf16x8*)(lds + PG8_SB(b, h) + boff + n * 2048 + k * 1024); } while (0)
#define PG8_MMA(ai, bj, At, Bt) do { __builtin_amdgcn_s_setprio(1); _Pragma("unroll") for (int m = 0; m < 4; ++m) _Pragma("unroll") for (int n = 0; n < 2; ++n) _Pragma("unroll") for (int k = 0; k < 2; ++k) \
        acc[ai][bj][m][n] = __builtin_amdgcn_mfma_f32_16x16x32_bf16(Bt[n][k], At[m][k], acc[ai][bj][m][n], 0, 0, 0); __builtin_amdgcn_s_setprio(0); } while (0)
#define PG8_RSS_PREFETCH(U, par) do { if constexpr (Epi::RSS_LDS) { int l2_; asm volatile("v_mbcnt_lo_u32_b32 %0, -1, 0\n\tv_mbcnt_hi_u32_b32 %0, -1, %0" : "=v"(l2_)); \
        __builtin_amdgcn_global_load_lds((const unsigned*)E.rowss + (size_t)(U).pm * BM + (wid & 3) * 64 + l2_, (PG8_LAS unsigned*)(lds + RSSTAB_OFF + ((par) & 1) * 1024 + (wid & 3) * 256), 4, 0, 0); } } while (0)
#define PG8_WAIT_V(n) asm volatile("s_waitcnt vmcnt(" #n ")" ::: "memory")
#define PG8_WAIT_L(n) asm volatile("s_waitcnt lgkmcnt(" #n ")" ::: "memory")
#define PG8_BAR __builtin_amdgcn_s_barrier()
#define PG8_SCHED __builtin_amdgcn_sched_barrier(0)
    Unit cur, nxt; int ui = 0;
    if (!S.next(0, cur)) return;
    f32x4 acc[2][2][4][2];
#pragma unroll
    for (int a = 0; a < 2; ++a)
#pragma unroll
        for (int b = 0; b < 2; ++b)
#pragma unroll
            for (int m = 0; m < 4; ++m)
#pragma unroll
                for (int n = 0; n < 2; ++n) acc[a][b][m][n] = (f32x4){0.f, 0.f, 0.f, 0.f};
    bf16x8 At[4][2], B0[2][2], B1[2][2];
    const char* cA = (const char*)g.A + PG8_AOFF(cur.pm); const char* cB = (const char*)g.Bt + (size_t)cur.pn * tstep;
    S.a_ready(cur);
    PG8_RSS_PREFETCH(cur, 0);
    if constexpr (SP2) {
        PG8_STAGE(PG8_SB(0, 0), cB, voffB); PG8_STAGE(PG8_SB(0, 1), cB + hstep, voffB); PG8_STAGE(PG8_SA(0, 0), cA, voffA); PG8_STAGE(PG8_SA(0, 1), cA + hstepA, voffA);
        if (wr == 1) PG8_BAR;
        PG8_WAIT_V(2); PG8_BAR;
        PG8_STAGE(PG8_SB(1, 0), cB + kstep, voffB); PG8_STAGE(PG8_SA(1, 0), cA + kstepA, voffA); PG8_STAGE(PG8_SB(1, 1), cB + hstep + kstep, voffB);
        PG8_WAIT_V(6); PG8_BAR;
    } else {
        PG8_STAGE(PG8_SB(0, 0), cB, voffB); PG8_STAGE(PG8_SA(0, 0), cA, voffA); PG8_STAGE(PG8_SB(0, 1), cB + hstep, voffB); PG8_STAGE(PG8_SA(0, 1), cA + hstepA, voffA);
        if (wr == 1) PG8_BAR;
        PG8_WAIT_V(4); PG8_BAR;
        PG8_STAGE(PG8_SB(1, 0), cB + kstep, voffB); PG8_STAGE(PG8_SA(1, 0), cA + kstepA, voffA); PG8_STAGE(PG8_SB(1, 1), cB + hstep + kstep, voffB);
        PG8_WAIT_V(6); PG8_BAR;
    }
    for (;;) {
        const bool has_next = S.next(ui + 1, nxt);
        const char* nA = has_next ? (const char*)g.A + PG8_AOFF(nxt.pm) : cA; const char* nB = has_next ? (const char*)g.Bt + (size_t)nxt.pn * tstep : cB;
        for (int t = 0; t < nt; t += 2) {
            const bool last = (t == nt - 2);
            const char* a1 = cA + (size_t)(t + 1) * kstepA;
            const char* a2 = last ? nA : cA + (size_t)(t + 2) * kstepA; const char* b2 = last ? nB : cB + (size_t)(t + 2) * kstep;
            const char* a3 = a2 + kstepA; const char* b3 = b2 + kstep;
            if (last && has_next) S.a_ready(nxt);
            if constexpr (SP2) {
            PG8_LDB(B0, 0, 0); PG8_LDB(B1, 0, 1); PG8_SCHED; PG8_LDA(At, 0, 0); PG8_STAGE(PG8_SA(1, 1), a1 + hstepA, voffA);
            PG8_WAIT_V(8); PG8_WAIT_L(0); PG8_BAR; PG8_MMA(0, 0, At, B0); PG8_MMA(0, 1, At, B1); PG8_BAR; PG8_SCHED;
            PG8_LDA(At, 0, 1); PG8_STAGE(PG8_SB(0, 0), b2, voffB); PG8_STAGE(PG8_SB(0, 1), b2 + hstep, voffB); PG8_STAGE(PG8_SA(0, 0), a2, voffA);
            PG8_WAIT_V(8); PG8_WAIT_L(0); PG8_BAR; PG8_MMA(1, 0, At, B0); PG8_MMA(1, 1, At, B1); PG8_BAR; PG8_SCHED;
            PG8_LDB(B0, 1, 0); PG8_LDB(B1, 1, 1); PG8_SCHED; PG8_LDA(At, 1, 0); PG8_STAGE(PG8_SA(0, 1), a2 + hstepA, voffA);
            PG8_WAIT_V(8); PG8_WAIT_L(0); PG8_BAR; PG8_MMA(0, 0, At, B0); PG8_MMA(0, 1, At, B1); PG8_BAR; PG8_SCHED;
            PG8_LDA(At, 1, 1); PG8_STAGE(PG8_SB(1, 0), b3, voffB); PG8_STAGE(PG8_SB(1, 1), b3 + hstep, voffB); PG8_STAGE(PG8_SA(1, 0), a3, voffA);
            PG8_WAIT_V(8); PG8_WAIT_L(0); PG8_BAR; PG8_MMA(1, 0, At, B0); PG8_MMA(1, 1, At, B1); PG8_BAR; PG8_SCHED;
            } else {
            PG8_LDB(B0, 0, 0); PG8_SCHED; PG8_LDA(At, 0, 0); PG8_STAGE(PG8_SA(1, 1), a1 + hstepA, voffA);
            PG8_WAIT_L(8); PG8_BAR; PG8_WAIT_L(0); PG8_MMA(0, 0, At, B0); PG8_BAR; PG8_SCHED;
            PG8_LDB(B1, 0, 1); PG8_STAGE(PG8_SB(0, 0), b2, voffB);
            PG8_BAR; PG8_WAIT_L(0); PG8_MMA(0, 1, At, B1); PG8_BAR;
            PG8_LDA(At, 0, 1); PG8_STAGE(PG8_SA(0, 0), a2, voffA);
            PG8_BAR; PG8_WAIT_L(0); PG8_MMA(1, 0, At, B0); PG8_BAR; PG8_SCHED;
            PG8_STAGE(PG8_SB(0, 1), b2 + hstep, voffB);
            PG8_WAIT_V(6); PG8_BAR; PG8_MMA(1, 1, At, B1); PG8_BAR;
            PG8_LDB(B0, 1, 0); PG8_SCHED; PG8_LDA(At, 1, 0); PG8_STAGE(PG8_SA(0, 1), a2 + hstepA, voffA);
            PG8_WAIT_L(8); PG8_BAR; PG8_WAIT_L(0); PG8_MMA(0, 0, At, B0); PG8_BAR; PG8_SCHED;
            PG8_LDB(B1, 1, 1); PG8_STAGE(PG8_SB(1, 0), b3, voffB);
            PG8_BAR; PG8_WAIT_L(0); PG8_MMA(0, 1, At, B1); PG8_BAR;
            PG8_LDA(At, 1, 1); PG8_STAGE(PG8_SA(1, 0), a3, voffA);
            PG8_BAR; PG8_WAIT_L(0); PG8_MMA(1, 0, At, B0); PG8_BAR; PG8_SCHED;
            PG8_STAGE(PG8_SB(1, 1), b3 + hstep, voffB);
            PG8_WAIT_V(6); PG8_BAR; PG8_MMA(1, 1, At, B1); PG8_BAR;
            }
        }
        if constexpr (ALIGN_EPI) { if (wr == 0) PG8_BAR; }
        if constexpr (Epi::RSS_LDS) { E(acc, cur, wr, wc, fr, fq, (const PG8_LAS unsigned*)(lds + RSSTAB_OFF + (ui & 1) * 1024)); S.done(cur); }
        else if constexpr (!Epi::AFTER_DRAIN) { E(acc, cur, wr, wc, fr, fq); S.done(cur); }
        if (!has_next) break;
#pragma unroll
        for (int a = 0; a < 2; ++a)
#pragma unroll
            for (int b = 0; b < 2; ++b)
#pragma unroll
                for (int m = 0; m < 4; ++m)
#pragma unroll
                    for (int n = 0; n < 2; ++n) acc[a][b][m][n] = (f32x4){0.f, 0.f, 0.f, 0.f};
        cur = nxt; cA = nA; cB = nB; ++ui;
        PG8_RSS_PREFETCH(cur, ui);
        if constexpr (ALIGN_EPI) { if (wr == 1) PG8_BAR; }
    }
    PG8_WAIT_V(0);
    if constexpr (!ALIGN_EPI) { if (wr == 0) PG8_BAR; }
    PG8_BAR;
    if constexpr (Epi::AFTER_DRAIN) { E.fused(acc, cur, wr, wc, fr, fq, lds, wid, lane); S.done(cur); }
#undef PG8_SA
#undef PG8_SB
#undef PG8_STAGE
#undef PG8_LDA
#undef PG8_LDB
#undef PG8_MMA
#undef PG8_WAIT_V
#undef PG8_AOFF
#undef PG8_RSS_PREFETCH
#undef PG8_WAIT_L
#undef PG8_BAR
#undef PG8_SCHED
}
}

constexpr int NWAVES = 8;
#ifndef MK_N_LAUNCHES
#define MK_N_LAUNCHES 1
#endif
constexpr int NPH = 12;
constexpr int N_LAUNCHES = MK_N_LAUNCHES;

constexpr int BATCH = 16, SEQ = 2048, DM = 1024, DEPTH = 2, M = BATCH * SEQ;
constexpr int PC = 3976, PCP = 4096, DFF = 2816, NGU = 2 * DFF;
constexpr int C_MQ = 0, C_MK = 256, C_MV = 512, C_MO = 768, C_MGI = 3968, C_MGF = 3972;
constexpr int C_RQ = 1024, C_RK = 1408, C_RV = 1792, C_RG = 2176;
constexpr int C_WR = 2560, C_WK = 2944, C_WV = 3328, C_WWL = 3712, C_WAL = 3776, C_WGL = 3840;
constexpr int WCOLS = 1408;
constexpr int Y_M = 0, Y_R = 256, Y_W = 640;

constexpr size_t MiB = 1u << 20;
constexpr size_t WS_CTL = 0, CTL_ZERO_BYTES = 2 * MiB;
constexpr size_t WS_RSS = 1 * MiB;
constexpr size_t WS_WIN = 2 * MiB, WS_WOUT = 18 * MiB, WS_WGU = 22 * MiB, WS_WDN = 44 * MiB;
constexpr size_t WS_LORA = 55 * MiB; constexpr int LORA_L = 384 * 256;
constexpr size_t WS_A1 = 56 * MiB;
constexpr size_t WS_XB = 120 * MiB;
constexpr size_t WS_XB2 = 440 * MiB;
constexpr size_t WS_A3 = 56 * MiB;
constexpr size_t WS_P = 184 * MiB;
constexpr size_t WS_END = 504 * MiB;
constexpr int CW_BAR = 4096;
constexpr int CW_PANEL = 16384;

constexpr int RING_OFF = 0, RING_BYTES = 131072;
constexpr int LDS_BYTES = 147456;
constexpr int LDSCTL_OFF = LDS_BYTES - 512, MISC_OFF = LDSCTL_OFF + 320;

#define GAS __attribute__((address_space(1)))
#define LAS __attribute__((address_space(3)))
typedef unsigned short bf16;
typedef unsigned v4u __attribute__((ext_vector_type(4)));
typedef float f32x4 __attribute__((ext_vector_type(4)));
typedef short bf16x8 __attribute__((ext_vector_type(8)));
typedef GAS unsigned gu32;
typedef GAS unsigned long long gu64;
#define RLX_AGENT __ATOMIC_RELAXED, __HIP_MEMORY_SCOPE_AGENT
#define LDS_WAIT() asm volatile("s_waitcnt lgkmcnt(0)" ::: "memory")
#define VM_WAIT() asm volatile("s_waitcnt vmcnt(0)" ::: "memory")
__device__ __forceinline__ unsigned long long rt() { return __builtin_amdgcn_s_memrealtime(); }
typedef __bf16 bf16v2_t __attribute__((ext_vector_type(2))); typedef float f32v2_t __attribute__((ext_vector_type(2)));
__device__ __forceinline__ unsigned pk2(float lo, float hi) { const f32v2_t f = {lo, hi}; const bf16v2_t v = __builtin_convertvector(f, bf16v2_t); return __builtin_bit_cast(unsigned, v); }
__device__ __forceinline__ unsigned f2bf(float f) { return pk2(f, f); }
#define XB_TMO      128
#define XB_XCNT(j)  (256  + 64 * (j))
#define XB_XSUB(j)  (1280 + 64 * (j))
#define XB_XGEN(j)  (2304 + 64 * (j))
#define XB_TOP      3328
#define XB_TOPGEN   3392
#define XCD_BAR_WORDS 3456
#define XB_SPIN_CAP (1u << 18)

__device__ __forceinline__ unsigned xb_ld(unsigned* p)              { return __hip_atomic_load(p, __ATOMIC_RELAXED, __HIP_MEMORY_SCOPE_AGENT); }
__device__ __forceinline__ unsigned xb_add(unsigned* p, unsigned v) { return __hip_atomic_fetch_add(p, v, __ATOMIC_RELAXED, __HIP_MEMORY_SCOPE_AGENT); }
__device__ __forceinline__ unsigned xb_xcc_id() { return (unsigned)__builtin_amdgcn_s_getreg((3 << 11) | 20) & 0xFu; }
#define XB_SPIN(cond, bar) do { unsigned _sp = 0; while (cond) { __builtin_amdgcn_s_sleep(1); \
    if ((++_sp & 255u) == 0u) { if (xb_ld(&(bar)[XB_TMO])) break; if (_sp > XB_SPIN_CAP) { atomicAdd(&(bar)[XB_TMO], 1u); break; } } } } while (0)

struct XcdBarrier {
    unsigned* bar; unsigned x;
    volatile LAS unsigned* st;
};

__device__ __forceinline__ XcdBarrier xcd_barrier_post(unsigned* bar, volatile LAS unsigned* st) {
    XcdBarrier b; b.bar = bar; b.x = xb_xcc_id(); b.st = st;
    if (threadIdx.x == 0) (void)xb_add(&bar[XB_XCNT(b.x)], 1u);
    return b;
}
__device__ __forceinline__ void xcd_barrier_complete(unsigned* bar, unsigned x, unsigned& nloc, unsigned& nx) {
    const unsigned G = gridDim.x * gridDim.y * gridDim.z;
    unsigned sum, cnt, mine, sp = 0u;
    for (;;) {
        sum = 0u; cnt = 0u; mine = 0u;
#pragma unroll
        for (unsigned j = 0; j < 16; ++j) { const unsigned c = xb_ld(&bar[XB_XCNT(j)]); sum += c; cnt += (c > 0u) ? 1u : 0u; mine = (j == x) ? c : mine; }
        if (sum == G) break;
        __builtin_amdgcn_s_sleep(1);
        if ((++sp & 255u) == 0u) { if (xb_ld(&bar[XB_TMO])) break; if (sp > XB_SPIN_CAP) { atomicAdd(&bar[XB_TMO], 1u); break; } }
    }
    nloc = mine > 0u ? mine : 1u; nx = cnt > 0u ? cnt : 1u;
}

__device__ __forceinline__ void xcd_barrier(const XcdBarrier& b, const bool leader  ,
                                            const bool release = true  ) {
    asm volatile("s_waitcnt vmcnt(0)" ::: "memory");
    __syncthreads();
    if (leader) {
        GAS unsigned* barg = (GAS unsigned*)b.bar; unsigned bx_ = b.x; asm volatile("" : "+s"(barg), "+s"(bx_)); unsigned* bar = (unsigned*)barg;
        __builtin_amdgcn_s_waitcnt(0);
        unsigned nloc = b.st[0], nx = b.st[1];
        if (nloc == 0u) { xcd_barrier_complete(bar, bx_, nloc, nx); b.st[0] = nloc; b.st[1] = nx; }
        const unsigned old = xb_add(&bar[XB_XSUB(bx_)], 1u);
        const unsigned gen = old / nloc;
        if (old + 1u == (gen + 1u) * nloc) {
            if (release) __builtin_amdgcn_fence(__ATOMIC_RELEASE, "agent");
            asm volatile("s_waitcnt vmcnt(0)" ::: "memory");
            const unsigned og = xb_add(&bar[XB_TOP], 1u);
            const unsigned tg = og / nx;
            if (og + 1u == (tg + 1u) * nx) xb_add(&bar[XB_TOPGEN], 1u);
            else XB_SPIN(xb_ld(&bar[XB_TOPGEN]) == tg, bar);
            __builtin_amdgcn_fence(__ATOMIC_ACQUIRE, "agent");
            xb_add(&bar[XB_XGEN(bx_)], 1u);
            asm volatile("s_waitcnt vmcnt(0)" ::: "memory");
        } else {
            XB_SPIN(xb_ld(&bar[XB_XGEN(bx_)]) == gen, bar);
            __builtin_amdgcn_fence(__ATOMIC_ACQUIRE, "agent");
            asm volatile("s_waitcnt vmcnt(0)" ::: "memory");
        }
    }
    __syncthreads();
}

struct Frame {
    LAS unsigned char* lds;
    volatile LAS unsigned* MISC;
    gu32* ctl;
    int wave;
    int vcu, G;
    float* out; unsigned char* ws;
};
__device__ __forceinline__ int flane() { int x; asm volatile("v_mbcnt_lo_u32_b32 %0, -1, 0\n\tv_mbcnt_hi_u32_b32 %0, -1, %0" : "=v"(x)); return x; }
#define FTID(F) ((F).wave * 64 + flane())
typedef unsigned u32x2_t __attribute__((ext_vector_type(2)));
struct Args { const float* in[24]; float* out; unsigned char* ws; int ph_lo, ph_hi, li, pad; };
template <int CTRL> __device__ __forceinline__ float dpp_mov(float x) { return __builtin_bit_cast(float, __builtin_amdgcn_update_dpp(0, __builtin_bit_cast(int, x), CTRL, 0xf, 0xf, true)); }
__device__ __forceinline__ float wave_sum(float x) {
    x += dpp_mov<0x140>(x); x += dpp_mov<0x141>(x); x += dpp_mov<0xB1>(x); x += dpp_mov<0x4E>(x);
    const int xi = __builtin_bit_cast(int, x);
    const float r0 = __builtin_bit_cast(float, __builtin_amdgcn_readlane(xi, 0)), r1 = __builtin_bit_cast(float, __builtin_amdgcn_readlane(xi, 16)),
                r2 = __builtin_bit_cast(float, __builtin_amdgcn_readlane(xi, 32)), r3 = __builtin_bit_cast(float, __builtin_amdgcn_readlane(xi, 48));
    return (r0 + r1) + (r2 + r3);
}
__device__ __forceinline__ float bperm(float x, int idx) { return __builtin_bit_cast(float, __builtin_amdgcn_ds_bpermute(idx << 2, __builtin_bit_cast(int, x))); }
__device__ __forceinline__ float red8(float x) { x += dpp_mov<0x141>(x); x += dpp_mov<0xB1>(x); x += dpp_mov<0x4E>(x); return x; }
__device__ __forceinline__ float bflo(unsigned w) { return __builtin_bit_cast(float, w << 16); }
__device__ __forceinline__ float bfhi(unsigned w) { return __builtin_bit_cast(float, w & 0xffff0000u); }
__device__ __forceinline__ void ld8g(const bf16* p, float (&v)[8]) { const v4u w = *(const v4u*)p;
    v[0] = bflo(w.x); v[1] = bfhi(w.x); v[2] = bflo(w.y); v[3] = bfhi(w.y); v[4] = bflo(w.z); v[5] = bfhi(w.z); v[6] = bflo(w.w); v[7] = bfhi(w.w); }
__device__ __forceinline__ void ld8l(const LAS bf16* p, float (&v)[8]) { const v4u w = *(const LAS v4u*)p;
    v[0] = bflo(w.x); v[1] = bfhi(w.x); v[2] = bflo(w.y); v[3] = bfhi(w.y); v[4] = bflo(w.z); v[5] = bfhi(w.z); v[6] = bflo(w.w); v[7] = bfhi(w.w); }
__device__ __forceinline__ void ld8f(const float* p, float (&v)[8]) { const f32x4 a = *(const f32x4*)p, b = *(const f32x4*)(p + 4);
    v[0] = a.x; v[1] = a.y; v[2] = a.z; v[3] = a.w; v[4] = b.x; v[5] = b.y; v[6] = b.z; v[7] = b.w; }
__device__ __forceinline__ void ld8lf(const LAS float* p, float (&v)[8]) { const f32x4 a = *(const LAS f32x4*)p, b = *(const LAS f32x4*)(p + 4);
    v[0] = a.x; v[1] = a.y; v[2] = a.z; v[3] = a.w; v[4] = b.x; v[5] = b.y; v[6] = b.z; v[7] = b.w; }
__device__ __forceinline__ void st8lf(LAS float* p, const float (&v)[8]) { *(LAS f32x4*)p = (f32x4){v[0], v[1], v[2], v[3]}; *(LAS f32x4*)(p + 4) = (f32x4){v[4], v[5], v[6], v[7]}; }
__device__ __forceinline__ v4u pack8(const float (&v)[8]) { v4u w; w.x = pk2(v[0], v[1]); w.y = pk2(v[2], v[3]); w.z = pk2(v[4], v[5]); w.w = pk2(v[6], v[7]); return w; }
__device__ __forceinline__ float sigmoid_f(float x) { return __builtin_amdgcn_rcpf(1.0f + __expf(-x)); }
__device__ __forceinline__ float silu2_f(float x) { return x * sigmoid_f(x); }
__device__ __forceinline__ float softplus_f(float z) { return fmaxf(z, 0.f) + __logf(1.0f + __expf(-fabsf(z))); }
__device__ __forceinline__ float tanh_f(float x) { return 1.0f - 2.0f * __builtin_amdgcn_rcpf(1.0f + __expf(2.0f * x)); }

__device__ __forceinline__ int p_colmap(int n) { return n < 1024 ? n : (n < 1032 ? 3968 + (n - 1024) : (n < PC ? n - 8 : n)); }
typedef short s16x4p_t __attribute__((ext_vector_type(4))); typedef unsigned u32x2p_t __attribute__((ext_vector_type(2)));
__device__ __forceinline__ void p0_transpose_item(const float* W, int K, int N, bf16* WT, int mode, LAS float* scr, int kb, int nb, int lane, const float* gain = nullptr) {
    LAS bf16* T = (LAS bf16*)scr;
    const int k0 = 64 * kb, n0 = 64 * nb, r = lane >> 4, c = lane & 15;
    const bool inb = (n0 + 4 * c) < N;
    f32x4 v[16];
#pragma unroll
    for (int j = 0; j < 16; ++j) v[j] = inb ? __builtin_nontemporal_load((const f32x4*)(W + (size_t)(k0 + 4 * j + r) * N + n0 + 4 * c)) : (f32x4){0.f, 0.f, 0.f, 0.f};
    if (gain) {
#pragma unroll
        for (int j = 0; j < 16; ++j) v[j] = v[j] * gain[k0 + 4 * j + r]; }
#pragma unroll
    for (int j = 0; j < 16; ++j) { u32x2p_t w; w.x = pk2(v[j].x, v[j].y); w.y = pk2(v[j].z, v[j].w); *(LAS u32x2p_t*)(T + (4 * j + r) * 72 + 4 * c) = w; }
    LDS_WAIT(); asm volatile("" ::: "memory");
    const int i = lane & 15, fq = lane >> 4;
#pragma unroll
    for (int nbk = 0; nbk < 4; ++nbk)
#pragma unroll
        for (int it = 0; it < 2; ++it) { const int kg = fq + 4 * it; const LAS bf16* a = T + (8 * kg + (i >> 2)) * 72 + 16 * nbk + 4 * (i & 3);
            const u32x2p_t lo = __builtin_bit_cast(u32x2p_t, __builtin_amdgcn_ds_read_tr16_b64_v4i16((LAS s16x4p_t*)a)), hi = __builtin_bit_cast(u32x2p_t, __builtin_amdgcn_ds_read_tr16_b64_v4i16((LAS s16x4p_t*)(a + 4 * 72)));
            const int ng = n0 + 16 * nbk + i; const int drow = (mode == 0) ? ng : (mode == 3) ? p_colmap(ng) : ((ng >> 7) * 256 + (ng & 127) + (mode == 2 ? 128 : 0));
            *(GAS v4u*)(WT + (size_t)drow * K + k0 + 8 * kg) = (v4u){lo.x, lo.y, hi.x, hi.y}; }
    LDS_WAIT(); asm volatile("" ::: "memory");
}
constexpr int I_IN = 16 * 64, I_OUT = 16 * 16, I_G = 16 * 44, I_D = 44 * 16, I_L = I_IN + I_OUT + 2 * I_G + I_D;
__device__ __forceinline__ void weight_item(Frame& F, const Args& A, LAS float* scr, int it, int lane_) {
    const int l = it / I_L; int r = it % I_L;
    if (r < I_IN) { p0_transpose_item(A.in[1] + (size_t)l * DM * PC, DM, PC, (bf16*)(F.ws + WS_WIN) + (size_t)l * PCP * DM, 3, scr, r / 64, r % 64, lane_, A.in[2] + l * DM); return; } r -= I_IN;
    if (r < I_OUT) { p0_transpose_item(A.in[20] + (size_t)l * DM * DM, DM, DM, (bf16*)(F.ws + WS_WOUT) + (size_t)l * DM * DM, 0, scr, r / 16, r % 16, lane_); return; } r -= I_OUT;
    if (r < I_G) { p0_transpose_item(A.in[21] + (size_t)l * DM * DFF, DM, DFF, (bf16*)(F.ws + WS_WGU) + (size_t)l * NGU * DM, 1, scr, r / 44, r % 44, lane_, A.in[3] + l * DM); return; } r -= I_G;
    if (r < I_G) { p0_transpose_item(A.in[22] + (size_t)l * DM * DFF, DM, DFF, (bf16*)(F.ws + WS_WGU) + (size_t)l * NGU * DM, 2, scr, r / 44, r % 44, lane_, A.in[3] + l * DM); return; } r -= I_G;
    p0_transpose_item(A.in[23] + (size_t)l * DFF * DM, DFF, DM, (bf16*)(F.ws + WS_WDN) + (size_t)l * DM * DFF, 0, scr, r / 16, r % 16, lane_);
}
__device__ __forceinline__ void lora_item(Frame& F, const Args& A, LAS float* scr, int l, int r, int lane_) {
    bf16* lw = (bf16*)(F.ws + WS_LORA) + (size_t)l * LORA_L;
    if (r < 6) p0_transpose_item(A.in[11] + (size_t)l * 64 * 384, 64, 384, lw, 0, scr, 0, r, lane_);
    else if (r < 12) p0_transpose_item(A.in[13] + (size_t)l * 64 * 384, 64, 384, lw + 384 * 64, 0, scr, 0, r - 6, lane_);
    else p0_transpose_item(A.in[14] + (size_t)l * 128 * 384, 128, 384, lw + 2 * 384 * 64, 0, scr, (r - 12) / 6, (r - 12) % 6, lane_);
}
constexpr int DW_L1 = 192 * NWAVES, DW_B = 256 * NWAVES, DW_A = DEPTH * I_L - I_IN - DW_L1 - DW_B;
__device__ __forceinline__ void deferred_weights(Frame& F, const Args& A, int l, int u) {
    const int lane_ = flane(); LAS float* scr = (LAS float*)(F.lds + RING_OFF + F.wave * 16384);
    const int gwo = u * NWAVES + F.wave, NGWO = 192 * NWAVES, NGWA = 256 * NWAVES;
    if (l == 0) {
        if (u < 192) for (int it = I_IN + gwo; it < I_IN + DW_A; it += NGWO) weight_item(F, A, scr, it, lane_);
        for (int it = I_IN + DW_A + gwo; it < I_IN + DW_A + DW_B; it += NGWA) weight_item(F, A, scr, it, lane_);
        if (u < 192 && NGWO - 1 - gwo < 24) lora_item(F, A, scr, 1, NGWO - 1 - gwo, lane_);
    } else if (u < 192) weight_item(F, A, scr, DEPTH * I_L - DW_L1 + gwo, lane_);
}
constexpr size_t XU_KB = (size_t)SEQ * 64;
__device__ __forceinline__ size_t xu_row(int m) { return ((size_t)(m >> 11) * 16 * SEQ + (m & (SEQ - 1))) * 64; }
__device__ __forceinline__ void p0_prologue(Frame& F, const Args& A) {
    const int lane_ = flane();
    LAS float* scr = (LAS float*)(F.lds + RING_OFF + F.wave * 16384);
    const int gw = F.vcu * NWAVES + F.wave, NGW = F.G * NWAVES;
    const float* x = A.in[0]; bf16* xb = (bf16*)(F.ws + WS_XB); float* rss = (float*)(F.ws + WS_RSS);
    for (int ph = 0; ph < 2; ++ph) {
        if ((ph ^ (F.wave & 1)) != 0) {
            for (int it = gw; it < I_IN; it += NGW) weight_item(F, A, scr, it, lane_);
            for (int r = gw; r < 24; r += NGW) lora_item(F, A, scr, 0, r, lane_);
            if (F.G != 256) { for (int it = I_IN + gw; it < DEPTH * I_L; it += NGW) weight_item(F, A, scr, it, lane_); for (int r = gw; r < 24; r += NGW) lora_item(F, A, scr, 1, r, lane_); }
        } else {
            for (int m = gw; m < M; m += 2 * NGW) {
                const int m2 = m + NGW < M ? m + NGW : m;
                const GAS f32x4* xr0 = (const GAS f32x4*)(x + (size_t)m * DM) + lane_; const GAS f32x4* xr1 = (const GAS f32x4*)(x + (size_t)m2 * DM) + lane_;
                f32x4 v0[4], v1[4]; float s0 = 0.f, s1 = 0.f;
#pragma unroll
                for (int j = 0; j < 4; ++j) { v0[j] = __builtin_nontemporal_load(xr0 + 64 * j); v1[j] = __builtin_nontemporal_load(xr1 + 64 * j); }
#pragma unroll
                for (int j = 0; j < 4; ++j) { s0 += (v0[j].x * v0[j].x + v0[j].y * v0[j].y) + (v0[j].z * v0[j].z + v0[j].w * v0[j].w); s1 += (v1[j].x * v1[j].x + v1[j].y * v1[j].y) + (v1[j].z * v1[j].z + v1[j].w * v1[j].w); }
                s0 = wave_sum(s0); s1 = wave_sum(s1);
                const size_t lo_ = (size_t)(lane_ >> 4) * XU_KB + 4 * (lane_ & 15);
                GAS unsigned long long* o0 = (GAS unsigned long long*)(xb + xu_row(m) + lo_); GAS unsigned long long* o1 = (GAS unsigned long long*)(xb + xu_row(m2) + lo_);
#pragma unroll
                for (int j = 0; j < 4; ++j) o0[XU_KB * j] = (unsigned long long)pk2(v0[j].x, v0[j].y) | ((unsigned long long)pk2(v0[j].z, v0[j].w) << 32);
                if (lane_ == 0) ((unsigned*)rss)[m] = (unsigned)(s0 * pg8::RSS_SCALE + 0.5f);
                if (m2 != m) {
#pragma unroll
                    for (int j = 0; j < 4; ++j) o1[XU_KB * j] = (unsigned long long)pk2(v1[j].x, v1[j].y) | ((unsigned long long)pk2(v1[j].z, v1[j].w) << 32);
                    if (lane_ == 0) ((unsigned*)rss)[m2] = (unsigned)(s1 * pg8::RSS_SCALE + 0.5f); }
            }
        }
    }
}
__device__ __forceinline__ void final_norm(Frame& F, const Args& A) {
    int lane_ = flane(); asm volatile("" : "+v"(lane_));
    const int gw = F.vcu * NWAVES + F.wave, NGW = F.G * NWAVES; const float* gf = A.in[4]; const bf16* xb = (const bf16*)(F.ws + WS_XB); const float* rss = (const float*)(F.ws + WS_RSS) + (size_t)4 * M;
    f32x4 gv[4];
#pragma unroll
    for (int j = 0; j < 4; ++j) gv[j] = ((const f32x4*)gf)[lane_ + 64 * j];
    for (int m = gw; m < M; m += 2 * NGW) {
        const int m2 = m + NGW < M ? m + NGW : m;
        const size_t lo_ = (size_t)(lane_ >> 4) * XU_KB + 4 * (lane_ & 15);
        const GAS unsigned long long* xr0 = (const GAS unsigned long long*)(xb + xu_row(m) + lo_); const GAS unsigned long long* xr1 = (const GAS unsigned long long*)(xb + xu_row(m2) + lo_);
        unsigned long long w0[4], w1[4];
#pragma unroll
        for (int j = 0; j < 4; ++j) { w0[j] = xr0[XU_KB * j]; w1[j] = xr1[XU_KB * j]; }
        const float rs0 = pg8::row_rstd(rss, m), rs1 = pg8::row_rstd(rss, m2);
        GAS f32x4* o0 = (GAS f32x4*)(F.out + (size_t)m * DM) + lane_; GAS f32x4* o1 = (GAS f32x4*)(F.out + (size_t)m2 * DM) + lane_;
#pragma unroll
        for (int j = 0; j < 4; ++j) { const unsigned lo = (unsigned)w0[j], hi = (unsigned)(w0[j] >> 32); o0[64 * j] = (f32x4){bflo(lo), bfhi(lo), bflo(hi), bfhi(hi)} * rs0 * gv[j]; }
        if (m2 != m) {
#pragma unroll
            for (int j = 0; j < 4; ++j) { const unsigned lo = (unsigned)w1[j], hi = (unsigned)(w1[j] >> 32); o1[64 * j] = (f32x4){bflo(lo), bfhi(lo), bflo(hi), bfhi(hi)} * rs1 * gv[j]; } }
    }
}

__device__ __forceinline__ int launder(int x) { asm volatile("" : "+v"(x)); return x; }
constexpr int XW_LD = 72, XG_LD = 136;
constexpr int TS = 72, US = 40;
constexpr int RO_WD = 0, RO_G = 16384, RO_AP = 32768, RO_X = 49152, RO_WT = 86016, RO_MU = 88064, RO_PAR = 89856, RO_TOP = 91648;
static_assert(RO_X + 35840 <= RO_WT && RO_TOP <= LDSCTL_OFF, "RWKV prep LDS map");
__device__ __forceinline__ v4u ldnt(const v4u* p) { return __builtin_nontemporal_load(p); }
__device__ __forceinline__ v4u ldnt(const GAS v4u* p) { return __builtin_nontemporal_load(p); }
struct Sh8 { v4u cur, prv; };
__device__ __forceinline__ void sh8_issue(Sh8& s, const bf16* prow, int pofs, int col) { s.cur = *(const v4u*)(prow + col); s.prv = *(const v4u*)(prow - pofs + col); }
__device__ __forceinline__ void sh8_pin(Sh8& s) { asm volatile("" : "+v"(s.cur), "+v"(s.prv)); }
__device__ __forceinline__ void unpack8(const v4u w, float (&v)[8]) { v[0] = bflo(w.x); v[1] = bfhi(w.x); v[2] = bflo(w.y); v[3] = bfhi(w.y); v[4] = bflo(w.z); v[5] = bfhi(w.z); v[6] = bflo(w.w); v[7] = bfhi(w.w); }
__device__ __forceinline__ void sh8_get(const Sh8& s, bool has_prev, const LAS float* mu8, float (&o)[8]) {
    float cur[8], prv[8], m8[8]; unpack8(s.cur, cur); unpack8(s.prv, prv); ld8lf(mu8, m8);
#pragma unroll
    for (int j = 0; j < 8; ++j) o[j] = cur[j] + m8[j] * ((has_prev ? prv[j] : 0.f) - cur[j]);
}
typedef short s16x4_t __attribute__((ext_vector_type(4)));
__device__ __forceinline__ bf16x8 tr_frag(const LAS bf16* blk, int ld, int lane) {
    const int i = lane & 15; const LAS bf16* a = blk + (i >> 2) * ld + 4 * (i & 3);
    const s16x4_t lo = __builtin_amdgcn_ds_read_tr16_b64_v4i16((LAS s16x4_t*)a), hi = __builtin_amdgcn_ds_read_tr16_b64_v4i16((LAS s16x4_t*)(a + 4 * ld));
    return (bf16x8){lo[0], lo[1], lo[2], lo[3], hi[0], hi[1], hi[2], hi[3]};
}
__device__ __forceinline__ u32x2_t tr4(const LAS bf16* blk, int ld, int lane) { const int i = lane & 15; const s16x4_t r = __builtin_amdgcn_ds_read_tr16_b64_v4i16((LAS s16x4_t*)(blk + (i >> 2) * ld + 4 * (i & 3))); return __builtin_bit_cast(u32x2_t, r); }
__device__ __forceinline__ bf16x8 frag2(u32x2_t lo, u32x2_t hi) { const v4u w = (v4u){lo.x, lo.y, hi.x, hi.y}; return __builtin_bit_cast(bf16x8, w); }
__device__ __forceinline__ u32x2_t cvt4(f32x4 a) { u32x2_t w; w.x = pk2(a[0], a[1]); w.y = pk2(a[2], a[3]); return w; }
#define MFMA16(a, b, c) __builtin_amdgcn_mfma_f32_16x16x32_bf16((a), (b), (c), 0, 0, 0)
#define LDFRAG(p) (*(const LAS bf16x8*)(p))
constexpr int TILE_B = 4 * 8192 + 8192 + 1024 + 256, TO_G = 32768, TO_GT = 40960, TO_BS = 41984;
static_assert((size_t)96 * 32 * TILE_B <= (size_t)M * DM * 4, "RWKV operand tiles fit in d_out");
__device__ __forceinline__ void rwkv_prep_block(Frame& F, const Args& A, int l, int u, int cb) {
    const int b = u / 6, h = u % 6;
    LAS unsigned char* L = F.lds;
    LAS float* Wd = (LAS float*)(L + RO_WD); LAS float* G = (LAS float*)(L + RO_G); LAS float* AP = (LAS float*)(L + RO_AP);
    LAS bf16* XW = (LAS bf16*)(L + RO_X); LAS bf16* XA = XW + 64 * XW_LD; LAS bf16* XG = XA + 64 * XW_LD;
    LAS float* WT = (LAS float*)(L + RO_WT); LAS float* MU = (LAS float*)(L + RO_MU); LAS float* PAR = (LAS float*)(L + RO_PAR);
    GAS unsigned char* wsu = (GAS unsigned char*)F.ws; asm volatile("" : "+s"(wsu)); const bf16* P = (const bf16*)(wsu + WS_P);
    GAS unsigned char* tiles = (GAS unsigned char*)F.out; asm volatile("" : "+s"(tiles));
    int tid_ = FTID(F); asm volatile("" : "+v"(tid_)); const int tid = tid_, tok_ = tid >> 3, cs_ = tid & 7;
    const int lane = tid & 63, fr = lane & 15, fq = lane >> 4, wave = F.wave;
    const int nt = wave & 3, mh = wave >> 2;
    const bf16* lw_ = (const bf16*)(wsu + WS_LORA) + (size_t)l * LORA_L;
    __syncthreads();
    if (tid < 448) { const float* mu = A.in[9] + (size_t)l * WCOLS; const int q = tid >> 6, ch = tid & 63;
        const int src = q < 3 ? (384 * q + 64 * h + ch) : (q < 5 ? (1152 + 64 * (q - 3) + ch) : (1280 + 64 * (q - 5) + ch)); MU[tid] = mu[src];
        const float* ps = q == 0 ? A.in[10] : q == 1 ? A.in[12] : q == 2 ? A.in[15] : q == 3 ? A.in[16] : q == 4 ? A.in[17] : q == 5 ? A.in[18] : A.in[19]; PAR[tid] = ps[l * 384 + 64 * h + ch]; }
    bf16x8 bw[2], ba[2], bg[4];
    { const int frl = launder(fr), fql = launder(fq);
        const bf16* pbw = lw_ + (size_t)(64 * h + 16 * nt + frl) * 64 + 8 * fql; const bf16* pba = pbw + 384 * 64; const bf16* pbg = lw_ + 2 * 384 * 64 + (size_t)(64 * h + 16 * nt + frl) * 128 + 8 * fql;
#pragma unroll
        for (int ks = 0; ks < 2; ++ks) { bw[ks] = *(const bf16x8*)(pbw + 32 * ks); ba[ks] = *(const bf16x8*)(pba + 32 * ks); }
#pragma unroll
        for (int ks = 0; ks < 4; ++ks) bg[ks] = *(const bf16x8*)(pbg + 32 * ks); }
    Sh8 s_wl, s_al, s_g0, s_g1;
#define RWP_ISSUE(cc) do { const int tok = launder(tok_), cs = launder(cs_); const bf16* prow = P + PU_L + ((size_t)b * SEQ + (cc) * 64 + tok) * 256; const int pofs = ((cc) * 64 + tok) > 0 ? 256 : 0; \
        sh8_issue(s_wl, prow, pofs, 8 * cs); sh8_issue(s_al, prow, pofs, 64 + 8 * cs); sh8_issue(s_g0, prow, pofs, 128 + 16 * cs); sh8_issue(s_g1, prow, pofs, 128 + 16 * cs + 8); } while (0)
    RWP_ISSUE(4 * cb);
    __syncthreads();
    float w0v[8], a0v[8], kkw[8], kaw[8], rk[8];
    ld8lf(PAR + 8 * cs_, w0v); ld8lf(PAR + 64 + 8 * cs_, a0v); ld8lf(PAR + 128 + 8 * cs_, kkw); ld8lf(PAR + 192 + 8 * cs_, kaw); ld8lf(PAR + 256 + 8 * cs_, rk);
    for (int ci = 0; ci < 4; ++ci) {
        const int c = 4 * cb + ci;
        const bool hp = (c * 64 + tok_) > 0;
        Sh8 s_r, s_k;
        { const int tok = launder(tok_), cs = launder(cs_); const bf16* prow = P + PU_W + (((size_t)b * 6 + h) * SEQ + c * 64 + tok) * 192; const int pofs = hp ? 192 : 0;
            sh8_issue(s_r, prow, pofs, 8 * cs); sh8_issue(s_k, prow, pofs, 64 + 8 * cs); }
        {
            const int tok = tok_, cs = cs_;
            sh8_pin(s_wl); sh8_pin(s_al); sh8_pin(s_g0); sh8_pin(s_g1);
            float x[8], y[8];
            sh8_get(s_wl, hp, MU + 192 + 8 * cs, x);
#pragma unroll
            for (int j = 0; j < 8; ++j) y[j] = tanh_f(x[j]);
            *(LAS v4u*)(XW + tok * XW_LD + 8 * cs) = pack8(y);
            sh8_get(s_al, hp, MU + 256 + 8 * cs, x);
            *(LAS v4u*)(XA + tok * XW_LD + 8 * cs) = pack8(x);
            sh8_get(s_g0, hp, MU + 320 + 16 * cs, x);
#pragma unroll
            for (int j = 0; j < 8; ++j) y[j] = sigmoid_f(x[j]);
            *(LAS v4u*)(XG + tok * XG_LD + 16 * cs) = pack8(y);
            sh8_get(s_g1, hp, MU + 320 + 16 * cs + 8, x);
#pragma unroll
            for (int j = 0; j < 8; ++j) y[j] = sigmoid_f(x[j]);
            *(LAS v4u*)(XG + tok * XG_LD + 16 * cs + 8) = pack8(y);
        }
        __syncthreads();
        {
            f32x4 cw[2], ca[2], cg[2];
#pragma unroll
            for (int m = 0; m < 2; ++m) { cw[m] = (f32x4){0.f, 0.f, 0.f, 0.f}; ca[m] = cw[m]; cg[m] = cw[m];
                const int arow = 32 * mh + 16 * m + fr;
#pragma unroll
                for (int ks = 0; ks < 2; ++ks) { const bf16x8 fw = LDFRAG(XW + arow * XW_LD + 32 * ks + 8 * fq), fa = LDFRAG(XA + arow * XW_LD + 32 * ks + 8 * fq);
                    cw[m] = MFMA16(fw, bw[ks], cw[m]); ca[m] = MFMA16(fa, ba[ks], ca[m]); }
#pragma unroll
                for (int ks = 0; ks < 4; ++ks) { const bf16x8 fg = LDFRAG(XG + arow * XG_LD + 32 * ks + 8 * fq); cg[m] = MFMA16(fg, bg[ks], cg[m]); } }
#pragma unroll
            for (int m = 0; m < 2; ++m)
#pragma unroll
                for (int i = 0; i < 4; ++i) { const int o = (32 * mh + 16 * m + 4 * fq + i) * 64 + 16 * nt + fr; Wd[o] = cw[m][i]; AP[o] = ca[m][i]; G[o] = cg[m][i]; }
        }
        __syncthreads();
        float r8[8], kk[8], ka[8], kp[8], lw[8], cumw[8], bs;
        {
            const int tok = tok_, cs = cs_;
            float wacc[8], aacc[8], k8[8];
            ld8lf(Wd + tok * 64 + 8 * cs, wacc); ld8lf(AP + tok * 64 + 8 * cs, aacc);
            sh8_pin(s_r); sh8_pin(s_k);
            sh8_get(s_r, hp, MU + 8 * cs, r8); sh8_get(s_k, hp, MU + 64 + 8 * cs, k8);
            float ss = 0.f, bsum = 0.f;
#pragma unroll
            for (int j = 0; j < 8; ++j) { lw[j] = -0.6065306597f * sigmoid_f(wacc[j] + w0v[j]);     const float a = sigmoid_f(aacc[j] + a0v[j]);
                kk[j] = k8[j] * kkw[j]; ss += kk[j] * kk[j]; kp[j] = k8[j] * (1.0f + (a - 1.0f) * kaw[j]); ka[j] = a; bsum += r8[j] * kp[j] * rk[j]; }
            ss = red8(ss); bs = red8(bsum); const float inv = fminf(__builtin_amdgcn_rsqf(ss), 1e12f);
#pragma unroll
            for (int j = 0; j < 8; ++j) { kk[j] *= inv; ka[j] *= kk[j]; }
#pragma unroll
            for (int j = 0; j < 8; ++j) cumw[j] = lw[j];
#pragma unroll
            for (int d = 1; d < 8; d <<= 1) { float y[8];
#pragma unroll
                for (int j = 0; j < 8; ++j) y[j] = bperm(cumw[j], lane - 8 * d);
                asm volatile("" : "+v"(y[0]), "+v"(y[1]), "+v"(y[2]), "+v"(y[3]), "+v"(y[4]), "+v"(y[5]), "+v"(y[6]), "+v"(y[7]));
                if ((lane >> 3) >= d) {
#pragma unroll
                    for (int j = 0; j < 8; ++j) cumw[j] += y[j]; } }
            if ((lane >> 3) == 7) st8lf(WT + wave * 64 + 8 * cs, cumw);
        }
        __syncthreads();
        if (ci < 3) RWP_ISSUE(c + 1);
        {
            const int tok = tok_, cs = cs_; const int t16 = tok & 15, sc = tok >> 4;
            GAS unsigned char* tb = tiles + (size_t)(u * 32 + c) * TILE_B;
            float cum[8];
#pragma unroll
            for (int j = 0; j < 8; ++j) cum[j] = cumw[j];
            if (wave & 1) { float x[8]; ld8lf(WT + (wave - 1) * 64 + 8 * cs, x);
#pragma unroll
                for (int j = 0; j < 8; ++j) cum[j] += x[j]; }
            float ah[8], bh[8], kh[8], rh[8], gam[8], g8[8];
#pragma unroll
            for (int j = 0; j < 8; ++j) { gam[j] = __expf(cum[j]); const float ginv = __expf(-cum[j]), gprev = __expf(cum[j] - lw[j]);
                ah[j] = gprev * kk[j]; bh[j] = ka[j] * ginv; kh[j] = kp[j] * ginv; rh[j] = gam[j] * r8[j]; }
            ld8lf(G + tok * 64 + 8 * cs, g8);
            GAS v4u* t16p = (GAS v4u*)(tb + tok * 128 + cs * 16);
            t16p[0] = pack8(ah); t16p[512] = pack8(bh); t16p[1024] = pack8(kh); t16p[1536] = pack8(rh); t16p[2048] = pack8(g8);
            if (t16 == 15) { GAS f32x4* gp = (GAS f32x4*)(tb + TO_GT + (sc * 64 + 8 * cs) * 4); gp[0] = (f32x4){gam[0], gam[1], gam[2], gam[3]}; gp[1] = (f32x4){gam[4], gam[5], gam[6], gam[7]}; }
            if (cs == 0) *(GAS float*)(tb + TO_BS + tok * 4) = bs;
        }
    }
    __syncthreads();
}

constexpr int SO_AH = 0, SO_BH = 9216, SO_KH = 18432, SO_RH = 27648, SO_VB = 36864  , SO_GT = 55296, SO_AAB = 56320, SO_AAK = 60416, SO_ARBK = 65536, SO_TIN = 70656,
              SO_YL = 75776  , SO_GB = 108544  , SO_BS = 126976  , SO_PAR = 127488, SO_END = 128256;
static_assert(SO_END <= LDSCTL_OFF, "RWKV scan LDS map");
__device__ __forceinline__ void rwkv_scan_unit(Frame& F, const Args& A, int l, int b, int h) {
    LAS unsigned char* L = F.lds;
    LAS bf16* AH = (LAS bf16*)(L + SO_AH); LAS bf16* BH = (LAS bf16*)(L + SO_BH); LAS bf16* KH = (LAS bf16*)(L + SO_KH); LAS bf16* RH = (LAS bf16*)(L + SO_RH); LAS bf16* Vb2 = (LAS bf16*)(L + SO_VB);
    LAS float* GT = (LAS float*)(L + SO_GT); LAS float* AAB = (LAS float*)(L + SO_AAB); LAS bf16* AAK = (LAS bf16*)(L + SO_AAK); LAS bf16* ARBK = (LAS bf16*)(L + SO_ARBK); LAS bf16* TIN = (LAS bf16*)(L + SO_TIN);
    LAS float* Yl2 = (LAS float*)(L + SO_YL); LAS bf16* Gb2 = (LAS bf16*)(L + SO_GB); LAS float* BS2 = (LAS float*)(L + SO_BS); LAS float* PAR = (LAS float*)(L + SO_PAR);
    GAS unsigned char* wsu = (GAS unsigned char*)F.ws; asm volatile("" : "+s"(wsu)); const bf16* P = (const bf16*)(wsu + WS_P); bf16* Yg = (bf16*)(wsu + WS_A1);
    GAS unsigned char* tiles = (GAS unsigned char*)F.out; asm volatile("" : "+s"(tiles));
    const int u = 6 * b + h;
    int tid_ = FTID(F); asm volatile("" : "+v"(tid_)); const int tid = tid_, tok_ = tid >> 3, cs_ = tid & 7;
    const int lane = tid & 63, fr = lane & 15, fq = lane >> 4, wave = F.wave;
    if (tid < 192) { const int q = tid >> 6, ch = tid & 63; PAR[tid] = q == 0 ? A.in[9][(size_t)l * WCOLS + 768 + 64 * h + ch] : (q == 1 ? A.in[18] : A.in[19])[l * 384 + 64 * h + ch]; }
    for (int o = tid * 16; o < SO_YL - SO_AAK; o += NWAVES * 64 * 16) *(LAS v4u*)(L + SO_AAK + o) = (v4u){0u, 0u, 0u, 0u};
    f32x4 accS[4];
#pragma unroll
    for (int q = 0; q < 4; ++q) accS[q] = (f32x4){0.f, 0.f, 0.f, 0.f};
    v4u t_ah, t_bh, t_kh, t_rh, t_g, t_gt; Sh8 s_v; float t_bs;
#define RWS_ISSUE(cc) do { const int tok = launder(tok_), cs = launder(cs_); GAS unsigned char* tb = tiles + (size_t)(u * 32 + (cc)) * TILE_B; const GAS v4u* tp = (const GAS v4u*)(tb + tok * 128 + cs * 16); \
        t_ah = ldnt(tp); t_bh = ldnt(tp + 512); t_kh = ldnt(tp + 1024); t_rh = ldnt(tp + 1536); t_g = ldnt(tp + 2048); t_gt = ldnt((const GAS v4u*)(tb + TO_GT + (tid & 63) * 16)); t_bs = *(const GAS float*)(tb + TO_BS + tok * 4); \
        const bf16* prow = P + PU_W + (((size_t)b * 6 + h) * SEQ + (cc) * 64 + tok) * 192; sh8_issue(s_v, prow, ((cc) * 64 + tok) > 0 ? 192 : 0, 128 + 8 * cs); } while (0)
#define RWS_PHASE_D(cd, it0) do { const int pb_ = (cd) & 1; \
        _Pragma("unroll") for (int rep = 0; rep < 2; ++rep) { const int it = (it0) + 256 * rep, tok = it >> 3, cs = it & 7; const size_t row = (size_t)b * SEQ + (cd) * 64 + tok; \
            float y[8], lg[8], lb[8], g8[8], v8[8], o[8]; \
            ld8lf(Yl2 + pb_ * 4096 + tok * 64 + 8 * cs, y); ld8l(Gb2 + pb_ * 4608 + tok * TS + 8 * cs, g8); ld8l(Vb2 + pb_ * 4608 + tok * TS + 8 * cs, v8); const float bs = BS2[pb_ * 64 + tok]; \
            ld8lf(PAR + 64 + 8 * cs, lg); ld8lf(PAR + 128 + 8 * cs, lb); \
            float s1 = 0.f; _Pragma("unroll") for (int j = 0; j < 8; ++j) s1 += y[j]; \
            const float mu_ = red8(s1) * (1.0f / 64.0f); float s2 = 0.f; \
            _Pragma("unroll") for (int j = 0; j < 8; ++j) { y[j] -= mu_; s2 += y[j] * y[j]; } \
            const float rstd = 1.0f / sqrtf(red8(s2) * (1.0f / 64.0f) + 64e-5f); \
            _Pragma("unroll") for (int j = 0; j < 8; ++j) o[j] = (y[j] * rstd * lg[j] + lb[j] + bs * v8[j]) * g8[j]; \
            *(v4u*)(Yg + (((size_t)b * 16 + 10 + h) * SEQ + (cd) * 64 + tok) * 64 + 8 * cs) = pack8(o); } } while (0)
    RWS_ISSUE(0);
    __syncthreads();
    for (int c = 0; c < SEQ / 64; ++c) {
        LAS bf16* Vb = Vb2 + (c & 1) * 4608; LAS float* Yl = Yl2 + (c & 1) * 4096;
        {
            const int tok = tok_, cs = cs_; const bool hp = (c * 64 + tok) > 0; float v8[8];
            asm volatile("" : "+v"(t_ah), "+v"(t_bh), "+v"(t_kh), "+v"(t_rh), "+v"(t_g), "+v"(t_gt), "+v"(t_bs)); sh8_pin(s_v);
            *(LAS v4u*)(AH + tok * TS + 8 * cs) = t_ah; *(LAS v4u*)(BH + tok * TS + 8 * cs) = t_bh; *(LAS v4u*)(KH + tok * TS + 8 * cs) = t_kh; *(LAS v4u*)(RH + tok * TS + 8 * cs) = t_rh;
            if (tid < 64) *(LAS v4u*)(GT + tid * 4) = t_gt;
            sh8_get(s_v, hp, PAR + 8 * cs, v8); *(LAS v4u*)(Vb + tok * TS + 8 * cs) = pack8(v8);
            *(LAS v4u*)(Gb2 + (c & 1) * 4608 + tok * TS + 8 * cs) = t_g; if (cs == 0) BS2[(c & 1) * 64 + tok] = t_bs;
            const int cn = c + 1 < SEQ / 64 ? c + 1 : c; RWS_ISSUE(cn);
        }
        __syncthreads();
        {
            const int sc = wave & 3;
#pragma unroll
            for (int x = 0; x < 3; ++x) { const int kind = (wave < 4) ? 0 : x + 1; if (wave < 4 && x > 0) break;
                const LAS bf16* A2 = ((kind & 2) ? RH : AH) + (16 * sc + fr) * TS + 8 * fq; const LAS bf16* B2 = ((kind & 1) ? KH : BH) + (16 * sc + fr) * TS + 8 * fq;
                bf16x8 fa0 = LDFRAG(A2), fa1 = LDFRAG(A2 + 32), fb0 = LDFRAG(B2), fb1 = LDFRAG(B2 + 32);
                asm volatile("" : "+v"(fa0), "+v"(fa1), "+v"(fb0), "+v"(fb1));
                f32x4 sm = (f32x4){0.f, 0.f, 0.f, 0.f};
                sm = MFMA16(fa0, fb0, sm); sm = MFMA16(fa1, fb1, sm);
#pragma unroll
                for (int i = 0; i < 4; ++i) { const int tt = 4 * fq + i, s_ = fr; const bool keep = (kind & 2) ? (s_ <= tt) : (s_ < tt); const float val = keep ? sm[i] : 0.f;
                    const int pp = 8 * (s_ >> 2) + (s_ & 3);
                    if (kind == 0) AAB[(sc * 16 + tt) * 16 + s_] = val; else if (kind == 1) AAK[(sc * 16 + tt) * US + pp + 4] = (bf16)f2bf(val);
                    else if (kind == 2) ARBK[(sc * 16 + tt) * US + pp] = (bf16)f2bf(val); else ARBK[(sc * 16 + tt) * US + pp + 4] = (bf16)f2bf(val); } }
            if (wave < 4) {
                const int cc = lane & 15; float xcol[16];
#pragma unroll
                for (int tb = 0; tb < 4; ++tb) {
                    f32x4 a4[4][4];
#pragma unroll
                    for (int r = 0; r < 4; ++r)
#pragma unroll
                        for (int q = 0; q <= tb; ++q) a4[r][q] = *(const LAS f32x4*)(AAB + (sc * 16 + 4 * tb + r) * 16 + 4 * q);
#pragma unroll
                    for (int r = 0; r < 4; ++r)
#pragma unroll
                        for (int q = 0; q <= tb; ++q) asm volatile("" : "+v"(a4[r][q]));
#pragma unroll
                    for (int r = 0; r < 4; ++r) { const int tt = 4 * tb + r; float x = (tt == cc) ? 1.0f : 0.0f;
#pragma unroll
                        for (int s_ = 0; s_ < 16; ++s_) if (s_ < tt) x -= a4[r][s_ >> 2][s_ & 3] * xcol[s_];
                        xcol[tt] = x; } }
#pragma unroll
                for (int tt = 0; tt < 16; ++tt) TIN[(sc * 16 + tt) * US + 8 * (cc >> 2) + (cc & 3)] = (bf16)f2bf(xcol[tt]);
            }
        }
        __syncthreads();
        if (wave >= 4) { if (c > 0) RWS_PHASE_D(c - 1, tid - 256); }
        else {
        bf16x8 fah[2], frh[2], abk[4], fak, frb, fti; f32x4 gt[4]; u32x2_t vtr;
#define RWS_LOADF(scn) do { const int t0_ = 16 * (scn); const LAS bf16* ahp = AH + (t0_ + fr) * TS + 4 * fq; const LAS bf16* rhp = RH + (t0_ + fr) * TS + 4 * fq; \
            _Pragma("unroll") for (int ks = 0; ks < 2; ++ks) { fah[ks] = frag2(*(const LAS u32x2_t*)(ahp + 32 * ks), *(const LAS u32x2_t*)(ahp + 32 * ks + 16)); frh[ks] = frag2(*(const LAS u32x2_t*)(rhp + 32 * ks), *(const LAS u32x2_t*)(rhp + 32 * ks + 16)); } \
            fak = LDFRAG(AAK + ((scn) * 16 + fr) * US + 8 * fq); frb = LDFRAG(ARBK + ((scn) * 16 + fr) * US + 8 * fq); fti = LDFRAG(TIN + ((scn) * 16 + fr) * US + 8 * fq); \
            vtr = tr4(Vb + (t0_ + 4 * fq) * TS + 16 * wave, TS, lane); \
            _Pragma("unroll") for (int kt = 0; kt < 4; ++kt) { abk[kt] = frag2(tr4(BH + (t0_ + 4 * fq) * TS + 16 * kt, TS, lane), tr4(KH + (t0_ + 4 * fq) * TS + 16 * kt, TS, lane)); gt[kt] = *(const LAS f32x4*)(GT + (scn) * 64 + 16 * kt + 4 * fq); } } while (0)
        RWS_LOADF(0);
#pragma unroll
        for (int sc = 0; sc < 4; ++sc) {
            const int t0 = 16 * sc;
            asm volatile("" : "+v"(fah[0]), "+v"(fah[1]), "+v"(frh[0]), "+v"(frh[1]), "+v"(fak), "+v"(frb), "+v"(fti), "+v"(vtr));
            asm volatile("" : "+v"(abk[0]), "+v"(abk[1]), "+v"(abk[2]), "+v"(abk[3]), "+v"(gt[0]), "+v"(gt[1]), "+v"(gt[2]), "+v"(gt[3]));
            const bf16x8 cfah0 = fah[0], cfah1 = fah[1], cfrh0 = frh[0], cfrh1 = frh[1], cfak = fak, cfrb = frb, cfti = fti, cabk0 = abk[0], cabk1 = abk[1], cabk2 = abk[2], cabk3 = abk[3];
            const f32x4 cgt0 = gt[0], cgt1 = gt[1], cgt2 = gt[2], cgt3 = gt[3]; const u32x2_t cvtr = vtr;
            if (sc < 3) RWS_LOADF(sc + 1);
            const u32x2_t z2 = (u32x2_t){0u, 0u};
            const bf16x8 bs0 = frag2(cvt4(accS[0]), cvt4(accS[1])), bs1 = frag2(cvt4(accS[2]), cvt4(accS[3]));
            f32x4 acc = (f32x4){0.f, 0.f, 0.f, 0.f}, accY = (f32x4){0.f, 0.f, 0.f, 0.f};
            acc = MFMA16(cfah0, bs0, acc); acc = MFMA16(cfah1, bs1, acc); acc = MFMA16(cfak, frag2(z2, cvtr), acc);
            accY = MFMA16(cfrh0, bs0, accY); accY = MFMA16(cfrh1, bs1, accY);
            const f32x4 uu = MFMA16(cfti, frag2(cvt4(-acc), z2), ((f32x4){0.f, 0.f, 0.f, 0.f}));
            const bf16x8 buv = frag2(cvt4(uu), cvtr);
            accY = MFMA16(cfrb, buv, accY);
#pragma unroll
            for (int i = 0; i < 4; ++i) Yl[(t0 + 4 * fq + i) * 64 + 16 * wave + fr] = accY[i];
            accS[0] = MFMA16(cabk0, buv, accS[0]); accS[0] = accS[0] * cgt0; accS[1] = MFMA16(cabk1, buv, accS[1]); accS[1] = accS[1] * cgt1;
            accS[2] = MFMA16(cabk2, buv, accS[2]); accS[2] = accS[2] * cgt2; accS[3] = MFMA16(cabk3, buv, accS[3]); accS[3] = accS[3] * cgt3;
        }
        }
        __syncthreads();
    }
    if (wave >= 4) RWS_PHASE_D(SEQ / 64 - 1, tid - 256);
    __syncthreads();
}
template <int CTRL, int ROWMASK> __device__ __forceinline__ float dpp_pull(float ident, float x) { return __builtin_bit_cast(float, __builtin_amdgcn_update_dpp(__builtin_bit_cast(int, ident), __builtin_bit_cast(int, x), CTRL, ROWMASK, 0xf, false)); }
__device__ __forceinline__ float scan_add64(float x, int) {
    x += dpp_pull<0x111, 0xf>(0.f, x); x += dpp_pull<0x112, 0xf>(0.f, x); x += dpp_pull<0x114, 0xf>(0.f, x); x += dpp_pull<0x118, 0xf>(0.f, x);
    x += dpp_pull<0x142, 0xa>(0.f, x); x += dpp_pull<0x143, 0xc>(0.f, x); return x;
}
__device__ __forceinline__ float scan_max64(float x, int) {
    const float NI = -3.0e38f;
    x = fmaxf(x, dpp_pull<0x111, 0xf>(NI, x)); x = fmaxf(x, dpp_pull<0x112, 0xf>(NI, x)); x = fmaxf(x, dpp_pull<0x114, 0xf>(NI, x)); x = fmaxf(x, dpp_pull<0x118, 0xf>(NI, x));
    x = fmaxf(x, dpp_pull<0x142, 0xa>(NI, x)); x = fmaxf(x, dpp_pull<0x143, 0xc>(NI, x)); return x;
}
template <bool ML> __device__ __forceinline__ void chunk_unit(Frame& F, const Args& A, int l, int b, int h) {
    LAS unsigned char* L = F.lds;
    constexpr int TSV = 88;
    LAS bf16* Qs = (LAS bf16*)L; LAS bf16* Ks = Qs + 64 * TS; LAS bf16* Kd = Ks + 64 * TS; LAS bf16* Pm = Kd + 64 * TS; LAS bf16* Vs = Pm + 64 * TS; LAS bf16* CT = Vs + 64 * TSV;
    LAS float* Hh = (LAS float*)(L + 59904); LAS float* DEN = (LAS float*)(L + 76288); LAS float* IG = (LAS float*)(L + 76544); LAS float* LF = IG + 64; LAS float* CW = LF + 64; LAS float* LNG = CW + 512;
    GAS unsigned char* wsu = (GAS unsigned char*)F.ws; asm volatile("" : "+s"(wsu));     const bf16* P = (const bf16*)(wsu + WS_P); bf16* Yg = (bf16*)(wsu + WS_A1);
    int tid_ = FTID(F); asm volatile("" : "+v"(tid_)); const int tid = tid_, tok_ = tid >> 3, cs_ = tid & 7;
    const int lane = tid & 63, fr = lane & 15, fq = lane >> 4, wave = F.wave;
    const int mt = wave & 3, half = wave >> 2, et0 = 2 * half; const bool aug = ML && half == 0;
    const float lgn = ML ? 0.f : log1pf(-exp2f(-5.0f - (float)h));
    for (int o = tid * 16; o < 64 * TSV * 2 + 80 * TS * 2; o += NWAVES * 64 * 16) *(LAS v4u*)((LAS unsigned char*)Vs + o) = (v4u){0u, 0u, 0u, 0u};
    __syncthreads();
    if (ML && tid < 64) Vs[tid * TSV + 64] = (bf16)0x3F80u;
    if (ML) { const float* convw = A.in[5] + (size_t)l * 4 * 512;
        if (tid < 256) { const int p = tid >> 7, c7 = tid & 127, col = c7 < 64 ? 64 * h + c7 : 256 + 64 * h + (c7 - 64); ((LAS unsigned*)CW)[tid] = pk2(convw[(2 * p) * 512 + col], convw[(2 * p + 1) * 512 + col]); }
        if (tid < 64) LNG[tid] = A.in[8][l * 256 + 64 * h + tid]; }
    const float gbi = ML ? A.in[6][l * 4 + h] : 0.f, gbf = ML ? A.in[7][l * 4 + h] : 0.f;
    f32x4 accC[3];
#pragma unroll
    for (int x = 0; x < 3; ++x) accC[x] = (f32x4){0.f, 0.f, 0.f, 0.f};
    float mst = -1e30f;
    v4u rw[10]; unsigned rgate = 0u;
#define CU_ISSUE(cc) do { const int tok = launder(tok_), cs = launder(cs_); const int t = (cc) * 64 + tok; const bf16* prow = P + (ML ? PU_M + (((size_t)b * 4 + h) * SEQ + t) * 256 : PU_R + (((size_t)b * 6 + h) * SEQ + t) * 256); \
        if (ML) { _Pragma("unroll") for (int jj = 0; jj < 4; ++jj) { const int tt = t - 3 + jj; const bf16* pr = P + PU_M + (((size_t)b * 4 + h) * SEQ + (tt >= 0 ? tt : 0)) * 256; \
                rw[2 * jj] = *(const v4u*)(pr + 8 * cs); rw[2 * jj + 1] = *(const v4u*)(pr + 64 + 8 * cs); } \
            rw[8] = ldnt((const v4u*)(prow + 128 + 8 * cs)); rw[9] = ldnt((const v4u*)(prow + 192 + 8 * cs)); \
            { const bf16* pl = P + PU_G + ((size_t)b * SEQ + (cc) * 64 + launder(lane)) * 8; rgate = (unsigned)pl[h] | ((unsigned)pl[4 + h] << 16); } } \
        else { const int i0 = 8 * (cs & 3); rw[0] = ldnt((const v4u*)(prow + i0)); rw[1] = ldnt((const v4u*)(prow + 32 + i0)); \
            rw[2] = ldnt((const v4u*)(prow + 64 + i0)); rw[3] = ldnt((const v4u*)(prow + 96 + i0)); rw[4] = ldnt((const v4u*)(prow + 128 + 8 * cs)); rw[5] = ldnt((const v4u*)(prow + 192 + 8 * cs)); } } while (0)
    CU_ISSUE(0);
    __syncthreads();
    for (int c = 0; c < SEQ / 64; ++c) {
        float k8[8]; v4u rgt; float ig_l = 0.f, lf_l = 0.f;
        {
            const int tok = tok_, cs = cs_; const int t = c * 64 + tok;
            if (ML) asm volatile("" : "+v"(rw[0]), "+v"(rw[1]), "+v"(rw[2]), "+v"(rw[3]), "+v"(rw[4]), "+v"(rw[5]), "+v"(rw[6]), "+v"(rw[7]), "+v"(rw[8]), "+v"(rw[9]), "+v"(rgate));
            else asm volatile("" : "+v"(rw[0]), "+v"(rw[1]), "+v"(rw[2]), "+v"(rw[3]), "+v"(rw[4]), "+v"(rw[5]));
            float q8[8], vv[8];
            if (ML) {
                if (c == 0) {
#pragma unroll
                    for (int jj = 0; jj < 3; ++jj) if (t - 3 + jj < 0) { rw[2 * jj] = (v4u){0u, 0u, 0u, 0u}; rw[2 * jj + 1] = (v4u){0u, 0u, 0u, 0u}; } }
                const LAS unsigned* CWP = (const LAS unsigned*)CW;
                v4u wq[2][2], wk[2][2];
#pragma unroll
                for (int p = 0; p < 2; ++p)
#pragma unroll
                    for (int hh = 0; hh < 2; ++hh) { wq[p][hh] = *(const LAS v4u*)(CWP + p * 128 + 8 * cs + 4 * hh); wk[p][hh] = *(const LAS v4u*)(CWP + p * 128 + 64 + 8 * cs + 4 * hh); }
#pragma unroll
                for (int i = 0; i < 4; ++i) {
#pragma unroll
                    for (int e = 0; e < 2; ++e) { const unsigned sel = e ? 0x07060302u : 0x05040100u; const int ch = 2 * i + e; float aq = 0.f, ak = 0.f;
#pragma unroll
                        for (int p = 0; p < 2; ++p) {
                            const unsigned xq = __builtin_amdgcn_perm(rw[2 * (2 * p + 1)][i], rw[2 * (2 * p)][i], sel), xk = __builtin_amdgcn_perm(rw[2 * (2 * p + 1) + 1][i], rw[2 * (2 * p) + 1][i], sel);
                            asm("v_dot2c_f32_bf16 %0, %1, %2" : "+v"(aq) : "v"(xq), "v"(wq[p][ch >> 2][ch & 3]));
                            asm("v_dot2c_f32_bf16 %0, %1, %2" : "+v"(ak) : "v"(xk), "v"(wk[p][ch >> 2][ch & 3])); }
                        q8[ch] = aq; k8[ch] = ak; } }
#pragma unroll
                for (int j = 0; j < 8; ++j) { q8[j] = silu2_f(q8[j]); k8[j] = silu2_f(k8[j]) * 0.125f; }
                unpack8(rw[8], vv); rgt = rw[9];
                { const float xf = bfhi(rgate) + gbf; ig_l = bflo(rgate & 0xffffu) + gbi; lf_l = fminf(xf, 0.f) - __logf(1.0f + __expf(-fabsf(xf))); }
            } else {
                const int i0 = 8 * (cs & 3);
                float q1[8], q2[8], k1[8], k2[8];
                unpack8(rw[0], q1); unpack8(rw[1], q2); unpack8(rw[2], k1); unpack8(rw[3], k2); unpack8(rw[4], vv); rgt = rw[5];
#pragma unroll
                for (int j = 0; j < 8; ++j) {
                    const float theta = exp2f(-(float)(i0 + j) * (13.287712379549449f / 31.0f));
                    float rev = (float)t * theta * 0.15915494309189535f; rev -= floorf(rev);
                    const float sn = __builtin_amdgcn_sinf(rev), cn = __builtin_amdgcn_cosf(rev);
                    if (cs < 4) { q8[j] = q1[j] * cn - q2[j] * sn; k8[j] = k1[j] * cn - k2[j] * sn; }
                    else        { q8[j] = q1[j] * sn + q2[j] * cn; k8[j] = k1[j] * sn + k2[j] * cn; }
                    k8[j] *= 0.125f;
                }
            }
            { const int cn = c + 1 < SEQ / 64 ? c + 1 : c; CU_ISSUE(cn); }
            *(LAS v4u*)(Qs + tok * TS + 8 * cs) = pack8(q8); *(LAS v4u*)(Ks + tok * TS + 8 * cs) = pack8(k8);
            *(LAS v4u*)(Vs + tok * TSV + 8 * cs) = pack8(vv);
        }
        float g, bj, iw, sw, dec, mrow = 0.f, mnew = 0.f;
        if (ML) { const float lf = lf_l, ig = ig_l; const float bc = scan_add64(lf, lane); g = ig - bc; const float Gp = scan_max64(g, lane);
            const float bL = bperm(bc, 63), Gm = bperm(Gp, 63); const float mx = fmaxf(mst, Gp); mrow = bc + mx; bj = -mx; iw = __expf(bc + mst - mrow);
            mnew = bL + fmaxf(mst, Gm); sw = __expf(bL + g - mnew); dec = __expf(bL + mst - mnew); }
        else { bj = (float)lane * lgn; g = -bj; iw = __expf((float)(lane + 1) * lgn); sw = __expf((float)(63 - lane) * lgn); dec = __expf(64.0f * lgn); }
        __syncthreads();
        {
            const float swt = bperm(sw, tok_); float kd[8];
#pragma unroll
            for (int j = 0; j < 8; ++j) kd[j] = k8[j] * swt;
            *(LAS v4u*)(Kd + tok_ * TS + 8 * cs_) = pack8(kd);
            const int st = wave >> 1;
            bf16x8 fk[2], fqa[2][2]; float gs[4], bjc[2];
#pragma unroll
            for (int ks = 0; ks < 2; ++ks) { fk[ks] = LDFRAG(Ks + (16 * st + fr) * TS + 32 * ks + 8 * fq);
#pragma unroll
                for (int jj = 0; jj < 2; ++jj) fqa[jj][ks] = LDFRAG(Qs + (16 * (2 * (wave & 1) + jj) + fr) * TS + 32 * ks + 8 * fq); }
#pragma unroll
            for (int i = 0; i < 4; ++i) gs[i] = bperm(g, 16 * st + 4 * fq + i);
#pragma unroll
            for (int jj = 0; jj < 2; ++jj) bjc[jj] = bperm(bj, 16 * (2 * (wave & 1) + jj) + fr);
            asm volatile("" : "+v"(fk[0]), "+v"(fk[1]), "+v"(fqa[0][0]), "+v"(fqa[0][1]), "+v"(fqa[1][0]), "+v"(fqa[1][1]), "+v"(gs[0]), "+v"(gs[1]), "+v"(gs[2]), "+v"(gs[3]), "+v"(bjc[0]), "+v"(bjc[1]));
#pragma unroll
            for (int jj = 0; jj < 2; ++jj) { const int jt = 2 * (wave & 1) + jj; u32x2_t w2; w2.x = 0u; w2.y = 0u;
                if (jt >= st) { f32x4 acc = (f32x4){0.f, 0.f, 0.f, 0.f};
#pragma unroll
                    for (int ks = 0; ks < 2; ++ks) acc = MFMA16(fk[ks], fqa[jj][ks], acc);
                    const int jc = 16 * jt + fr; float p[4];
#pragma unroll
                    for (int i = 0; i < 4; ++i) { const int s = 16 * st + 4 * fq + i; p[i] = (s <= jc) ? acc[i] * __expf(bjc[jj] + gs[i]) : 0.f; }
                    w2.x = pk2(p[0], p[1]); w2.y = pk2(p[2], p[3]); }
                *(LAS u32x2_t*)(Pm + (16 * jt + fr) * TS + 16 * st + 4 * fq) = w2; }
        }
        __syncthreads();
        {
            float iwr[4]; bf16x8 aq[2], ap[2], akd[2], bc[3][2], bv[3][2];
#pragma unroll
            for (int i = 0; i < 4; ++i) iwr[i] = bperm(iw, 16 * mt + 4 * fq + i);
#pragma unroll
            for (int ks = 0; ks < 2; ++ks) { aq[ks] = LDFRAG(Qs + (16 * mt + fr) * TS + 32 * ks + 8 * fq); ap[ks] = LDFRAG(Pm + (16 * mt + fr) * TS + 32 * ks + 8 * fq); akd[ks] = tr_frag(Kd + (32 * ks + 8 * fq) * TS + 16 * mt, TS, lane);
#pragma unroll
                for (int x = 0; x < 3; ++x) { const int et = (x == 2) ? (aug ? 4 : et0) : et0 + x; bc[x][ks] = LDFRAG(CT + (16 * et + fr) * TS + 32 * ks + 8 * fq); bv[x][ks] = tr_frag(Vs + (32 * ks + 8 * fq) * TSV + 16 * et, TSV, lane); } }
            asm volatile("" : "+v"(aq[0]), "+v"(aq[1]), "+v"(ap[0]), "+v"(ap[1]), "+v"(akd[0]), "+v"(akd[1]), "+v"(iwr[0]), "+v"(iwr[1]), "+v"(iwr[2]), "+v"(iwr[3]));
            asm volatile("" : "+v"(bc[0][0]), "+v"(bc[0][1]), "+v"(bc[1][0]), "+v"(bc[1][1]), "+v"(bc[2][0]), "+v"(bc[2][1]), "+v"(bv[0][0]), "+v"(bv[0][1]), "+v"(bv[1][0]), "+v"(bv[1][1]), "+v"(bv[2][0]), "+v"(bv[2][1]));
#pragma unroll
            for (int x = 0; x < 3; ++x) { if (x == 2 && !aug) break; const int et = (x == 2) ? 4 : et0 + x;
                f32x4 acc = (f32x4){0.f, 0.f, 0.f, 0.f};
#pragma unroll
                for (int ks = 0; ks < 2; ++ks) acc = MFMA16(aq[ks], bc[x][ks], acc);
#pragma unroll
                for (int i = 0; i < 4; ++i) acc[i] *= iwr[i];
#pragma unroll
                for (int ks = 0; ks < 2; ++ks) acc = MFMA16(ap[ks], bv[x][ks], acc);
                if (x < 2) {
#pragma unroll
                    for (int i = 0; i < 4; ++i) Hh[(16 * mt + 4 * fq + i) * 64 + 16 * et + fr] = acc[i]; }
                else if (fr == 0) {
#pragma unroll
                    for (int i = 0; i < 4; ++i) DEN[16 * mt + 4 * fq + i] = acc[i]; }
                accC[x] = accC[x] * dec;
#pragma unroll
                for (int ks = 0; ks < 2; ++ks) accC[x] = MFMA16(akd[ks], bv[x][ks], accC[x]);
            }
        }
        __syncthreads();
        {
#pragma unroll
            for (int x = 0; x < 3; ++x) { if (x == 2 && !aug) break; const int et = (x == 2) ? 4 : et0 + x;
                u32x2_t w2; w2.x = pk2(accC[x][0], accC[x][1]); w2.y = pk2(accC[x][2], accC[x][3]);
                *(LAS u32x2_t*)(CT + (16 * et + fr) * TS + 16 * mt + 4 * fq) = w2; }
            const int tok = launder(tok_), cs = launder(cs_); const size_t row = (size_t)b * SEQ + c * 64 + tok;
            float y[8], gt[8], o[8]; ld8lf(Hh + tok * 64 + 8 * cs, y); unpack8(rgt, gt);
            if (ML) { const float mr = bperm(mrow, tok_); const float sc_ = __builtin_amdgcn_rcpf(fmaxf(fabsf(DEN[tok]), __expf(-mr)));
#pragma unroll
                for (int j = 0; j < 8; ++j) y[j] *= sc_; }
            float s1 = 0.f;
#pragma unroll
            for (int j = 0; j < 8; ++j) s1 += y[j];
            const float mu = red8(s1) * (1.0f / 64.0f); float s2 = 0.f;
#pragma unroll
            for (int j = 0; j < 8; ++j) { y[j] -= mu; s2 += y[j] * y[j]; }
            const float rstd = 1.0f / sqrtf(red8(s2) * (1.0f / 64.0f) + 1e-5f);
            if (ML) { float gl[8]; ld8lf(LNG + 8 * cs, gl);
#pragma unroll
                for (int j = 0; j < 8; ++j) o[j] = sigmoid_f(gt[j]) * y[j] * rstd * gl[j]; }
            else {
#pragma unroll
                for (int j = 0; j < 8; ++j) o[j] = silu2_f(gt[j]) * y[j] * rstd; }
            *(v4u*)(Yg + (((size_t)b * 16 + (ML ? 0 : 4) + h) * SEQ + c * 64 + tok) * 64 + 8 * cs) = pack8(o);
            mst = mnew;
        }
    }
    __syncthreads();
}
__device__ __forceinline__ void mixer_phase(Frame& F, const Args& A, int l) {
    int u0 = F.vcu;
    if (F.G == 256) { const int b = 2 * (F.vcu >> 5) + ((F.vcu >> 4) & 1), hd = F.vcu & 15; u0 = hd < 4 ? 192 + 4 * b + hd : (hd < 10 ? 96 + 6 * b + (hd - 4) : 6 * b + (hd - 10)); }
    for (int u = u0; u < 256; u += F.G) {
        if (u < 96) rwkv_scan_unit(F, A, l, u / 6, u % 6);
        else if (u < 192) chunk_unit<false>(F, A, l, (u - 96) / 6, (u - 96) % 6);
        else chunk_unit<true>(F, A, l, (u - 192) / 4, (u - 192) % 4);
        if (F.G == 256) deferred_weights(F, A, l, u);
    }
}

__global__ void __launch_bounds__(NWAVES * 64, 2) hyb_fwd(Args args) {
    extern __shared__ __attribute__((aligned(16))) unsigned char lds[];
    Frame F;
    F.lds = (LAS unsigned char*)lds;
    F.MISC = (volatile LAS unsigned*)(F.lds + MISC_OFF);
    F.wave = __builtin_amdgcn_readfirstlane(threadIdx.x >> 6);
    F.G = gridDim.x; { const int bx = blockIdx.x; F.vcu = (F.G % 8 == 0) ? (bx % 8) * (F.G / 8) + bx / 8 : bx; }
    F.ws = args.ws; F.out = args.out; F.ctl = (gu32*)(args.ws + WS_CTL);
    for (int u = threadIdx.x; u < (LDS_BYTES - LDSCTL_OFF) / 4; u += NWAVES * 64) ((LAS unsigned*)(F.lds + LDSCTL_OFF))[u] = 0u;
    __syncthreads();
    XcdBarrier bar; bar.bar = (unsigned*)(F.ctl + CW_BAR); bar.x = 0; bar.st = nullptr;
    if (N_LAUNCHES == 1) bar = xcd_barrier_post((unsigned*)(F.ctl + CW_BAR), F.MISC + 8);
#define GRID_BAR() do { if (N_LAUNCHES == 1) xcd_barrier(bar, F.wave == 0 && flane() == 0); } while (0)
#define GRID_BAR_WT() do { if (N_LAUNCHES == 1) xcd_barrier(bar, F.wave == 0 && flane() == 0, false); } while (0)
    const int lo = args.ph_lo, hi = args.ph_hi;
#define IN(k) (N_LAUNCHES == 1 || (lo <= (k) && (k) < hi))
#define BOTH(k) (IN(k) && IN((k) + 1))

    if (IN(0)) { p0_prologue(F, args); if (BOTH(0)) GRID_BAR(); }
    for (int l = 0; l < DEPTH; ++l) {
        const int pb = 1 + 5 * l;
        GAS unsigned char* wsl = (GAS unsigned char*)args.ws; asm volatile("" : "+s"(wsl));
        float* rss = (float*)(wsl + WS_RSS); bf16* A1 = (bf16*)(wsl + WS_A1); bf16* XB = (bf16*)(wsl + WS_XB); bf16* XB2 = (bf16*)(wsl + WS_XB2); bf16* PB = (bf16*)(wsl + WS_P);
        if (IN(pb)) {
            pg8::Gemm g{XB, (const bf16*)(wsl + WS_WIN) + (size_t)l * PCP * DM, M, PCP, DM}; pg8::StaticOrder S; S.init(M, PCP, F.G, (int)blockIdx.x);
            pg8::EpiP E{PB, rss + (size_t)(2 * l) * M};
            pg8::gemm_phase<pg8::EpiP, pg8::StaticOrder, true, true, true>(F.lds + RING_OFF, g, S, E, F.wave);
            if (BOTH(pb)) GRID_BAR_WT();
        }
        if (IN(pb + 1)) {
            if (F.G == 256) {
                _Pragma("unroll 1") for (int i = 0; i < 3; ++i) { const int tl = (F.vcu & 31) + 32 * i, bl = tl / 48, rem = tl - 48 * bl; rwkv_prep_block(F, args, l, 6 * (2 * (F.vcu >> 5) + bl) + (rem >> 3), rem & 7); }
            } else for (int k = F.vcu; k < 768; k += F.G) rwkv_prep_block(F, args, l, k >> 3, k & 7);
            GRID_BAR();
            mixer_phase(F, args, l); if (BOTH(pb + 1)) GRID_BAR();
        }
        if (IN(pb + 2)) {
            pg8::Gemm g{A1, (const bf16*)(wsl + WS_WOUT) + (size_t)l * DM * DM, M, DM, DM}; pg8::StaticOrder S; S.init(M, DM, F.G, (int)blockIdx.x);
            pg8::EpiRes E{XB, XB2, rss + (size_t)(2 * l + 1) * M, DM};
            pg8::gemm_phase<pg8::EpiRes, pg8::StaticOrder, true, true, true>(F.lds + RING_OFF, g, S, E, F.wave);
            if (BOTH(pb + 2)) GRID_BAR();
        }
        if (IN(pb + 3)) {
            pg8::Gemm g{XB2, (const bf16*)(wsl + WS_WGU) + (size_t)l * NGU * DM, M, NGU, DM}; pg8::StaticOrder S; S.init(M, NGU, F.G, (int)blockIdx.x);
            pg8::EpiSwiGLU E{PB, DFF, rss + (size_t)(2 * l + 1) * M};
            pg8::gemm_phase<pg8::EpiSwiGLU, pg8::StaticOrder, true, true, true>(F.lds + RING_OFF, g, S, E, F.wave);
            if (BOTH(pb + 3)) GRID_BAR_WT();
        }
        if (IN(pb + 4)) {
            pg8::Gemm g{PB, (const bf16*)(wsl + WS_WDN) + (size_t)l * DM * DFF, M, DM, DFF}; pg8::StaticOrder S; S.init(M, DM, F.G, (int)blockIdx.x);
            if (l < DEPTH - 1 || F.G != 256) {
                pg8::EpiRes E{XB2, XB, rss + (size_t)(2 * l + 2) * M, DM};
                pg8::gemm_phase<pg8::EpiRes, pg8::StaticOrder, true, true>(F.lds + RING_OFF, g, S, E, F.wave);
                if (BOTH(pb + 4)) GRID_BAR();
            } else {
                pg8::EpiResFinal E{XB2, (float*)args.out, rss + (size_t)(2 * l + 2) * M, args.in[4], (unsigned*)(wsl + WS_CTL) + CW_PANEL, DM};
                pg8::gemm_phase<pg8::EpiResFinal, pg8::StaticOrder, true, true>(F.lds + RING_OFF, g, S, E, F.wave);
            }
        }
    }
    if (F.G != 256 && IN(NPH - 1)) final_norm(F, args);
#undef IN
#undef BOTH
}

extern "C" void kernel_launch(void* const* d_in, const int* in_sizes, int n_in, void* d_out, int out_size, void* d_ws, size_t ws_size, hipStream_t stream) {
    static int grid = 0;
    if (grid == 0) {
        if (n_in != 24 || in_sizes[0] != M * DM || out_size != M * DM || ws_size < WS_END) { fprintf(stderr, "kernel_launch: unexpected shapes: n_in %d in0 %d out %d ws %zu (need %zu)\n", n_in, n_in > 0 ? in_sizes[0] : -1, out_size, ws_size, (size_t)WS_END); grid = -1; return; }
        int dev = 0, cus = 0;
        if (hipGetDevice(&dev) != hipSuccess || hipDeviceGetAttribute(&cus, hipDeviceAttributeMultiprocessorCount, dev) != hipSuccess) { grid = -1; return; }
        if (hipFuncSetAttribute((const void*)hyb_fwd, hipFuncAttributeMaxDynamicSharedMemorySize, LDS_BYTES) != hipSuccess) { fprintf(stderr, "kernel_launch: hipFuncSetAttribute failed\n"); grid = -1; return; }
        int per_cu = 0;
        if (hipOccupancyMaxActiveBlocksPerMultiprocessor(&per_cu, (const void*)hyb_fwd, NWAVES * 64, LDS_BYTES) != hipSuccess || per_cu < 1) fprintf(stderr, "kernel_launch: occupancy query says %d\n", per_cu);
        (void)hipGetLastError();
        grid = cus;
    }
    if (grid < 0) return;
    if (hipMemsetAsync((char*)d_ws + WS_CTL, 0, CTL_ZERO_BYTES, stream) != hipSuccess) return;
    Args a{};
    for (int i = 0; i < 24; ++i) a.in[i] = (const float*)d_in[i];
    a.out = (float*)d_out; a.ws = (unsigned char*)d_ws;
    for (int li = 0; li < N_LAUNCHES; ++li) {
        a.ph_lo = (N_LAUNCHES == 1) ? 0 : li; a.ph_hi = (N_LAUNCHES == 1) ? NPH : li + 1; a.li = li;
        hipLaunchKernelGGL(hyb_fwd, dim3(grid), dim3(NWAVES * 64), LDS_BYTES, stream, a);
        if (hipPeekAtLastError() != hipSuccess) { fprintf(stderr, "kernel_launch: launch %d failed\n", li); break; }
    }
}
```
